# Optimizing an MI355X kernel written in HIP

```python
import jax, jax.numpy as jnp
from jax import lax
import numpy as np

D_MODEL = 1024
BATCH = 16
SEQ = 2048
DEPTH = 2

N_META = 16
HEAD_DIM = 64
N_Q_HEADS = D_MODEL // HEAD_DIM
N_KV_HEADS = N_Q_HEADS // 4
GQA_GROUP = N_Q_HEADS // N_KV_HEADS
WINDOW = 128
BLOCK = 128
POOL_WINDOWS = (2, 4, 8, 16)
N_POOL_GROUPS = len(POOL_WINDOWS)
POOL_GROUP_DIM = D_MODEL // N_POOL_GROUPS
D_FF = ((8 * D_MODEL // 3 + 255) // 256) * 256
N_MIXERS = 2
N_ATTN_LAYERS = (DEPTH + 1) // N_MIXERS
N_POOL_LAYERS = DEPTH // N_MIXERS
QKV_DIM = (N_Q_HEADS + 2 * N_KV_HEADS) * HEAD_DIM
RMS_EPS = 1e-6
NEG_INF = -1e30

kernel_name = 'hybrid_window_gqa_multiscale_pool_macaron'


def rms_norm(x, g):
    xf = x.astype(jnp.float32)
    y = xf * lax.rsqrt(jnp.mean(xf * xf, axis=-1, keepdims=True) + RMS_EPS)
    return (y * g.astype(jnp.float32)).astype(x.dtype)


def swiglu(x, w_gu, w_down):
    g, u = jnp.split(x @ w_gu, 2, axis=-1)
    return (jax.nn.silu(g) * u) @ w_down


def alibi_slopes(n):
    return jnp.exp2(-8.0 * jnp.arange(1, n + 1, dtype=jnp.float32) / n)


def windowed_gqa_attention(h, w_qkv, q_gain, k_gain, sink, w_o):
    B, L, _ = h.shape
    S = L - N_META
    nb = S // BLOCK
    f32 = jnp.float32
    q, k, v = jnp.split(h @ w_qkv, [N_Q_HEADS * HEAD_DIM, (N_Q_HEADS + N_KV_HEADS) * HEAD_DIM], axis=-1)
    q = rms_norm(q.reshape(B, L, N_KV_HEADS, GQA_GROUP, HEAD_DIM), q_gain) * (HEAD_DIM ** -0.5)
    k = rms_norm(k.reshape(B, L, N_KV_HEADS, HEAD_DIM), k_gain)
    v = v.reshape(B, L, N_KV_HEADS, HEAD_DIM)
    qm, qr = q[:, :N_META], q[:, N_META:]
    km, kr = k[:, :N_META], k[:, N_META:]
    vm, vr = v[:, :N_META], v[:, N_META:]
    slopes = alibi_slopes(N_Q_HEADS).reshape(N_KV_HEADS, GQA_GROUP)
    sink = sink.astype(f32).reshape(N_KV_HEADS, GQA_GROUP)

    qb = qr.reshape(B, nb, BLOCK, N_KV_HEADS, GQA_GROUP, HEAD_DIM)

    def band(t):
        tp = jnp.pad(t, ((0, 0), (BLOCK, BLOCK), (0, 0), (0, 0))).reshape(B, nb + 2, BLOCK, N_KV_HEADS, HEAD_DIM)
        return jnp.concatenate([tp[:, :-2], tp[:, 1:-1], tp[:, 2:]], axis=2)

    kb, vb = band(kr), band(vr)
    s_band = jnp.einsum('bnqkgd,bnckd->bnkgqc', qb, kb).astype(f32)
    s_meta = jnp.einsum('bnqkgd,bmkd->bnkgqm', qb, km).astype(f32)
    a = jnp.arange(BLOCK)
    c = jnp.arange(3 * BLOCK)
    blk = jnp.arange(nb)
    rel = c[None, :] - BLOCK - a[:, None]
    key_idx = blk[:, None] * BLOCK - BLOCK + c[None, :]
    valid = (jnp.abs(rel) <= WINDOW)[None] & ((key_idx >= 0) & (key_idx < S))[:, None, :]
    band_bias = -slopes[:, :, None, None] * jnp.abs(rel).astype(f32)
    s_band = jnp.where(valid[None, :, None, None], s_band + band_bias[None, None], NEG_INF)
    t_glob = N_META + blk[:, None] * BLOCK + a[None, :]
    meta_dist = (t_glob[:, :, None] - jnp.arange(N_META)[None, None, :]).astype(f32)
    s_meta = s_meta - slopes[:, :, None, None] * meta_dist[:, None, None]
    sink_col = jnp.broadcast_to(sink[:, :, None, None], s_band.shape[:-1] + (1,))
    p = jax.nn.softmax(jnp.concatenate([s_meta, s_band, sink_col], axis=-1), axis=-1)[..., :-1].astype(h.dtype)
    o_r = (jnp.einsum('bnkgqm,bmkd->bnqkgd', p[..., :N_META], vm)
           + jnp.einsum('bnkgqc,bnckd->bnqkgd', p[..., N_META:], vb))
    o_r = o_r.reshape(B, S, N_Q_HEADS * HEAD_DIM)

    k_mq = jnp.concatenate([km, kr[:, :BLOCK]], axis=1)
    v_mq = jnp.concatenate([vm, vr[:, :BLOCK]], axis=1)
    s_mq = jnp.einsum('bpkgd,bskd->bkgps', qm, k_mq).astype(f32)
    dist = jnp.abs(jnp.arange(N_META)[:, None] - jnp.arange(N_META + BLOCK)[None, :])
    s_mq = jnp.where(dist <= WINDOW, s_mq - slopes[:, :, None, None] * dist.astype(f32), NEG_INF)
    sink_mq = jnp.broadcast_to(sink[:, :, None, None], s_mq.shape[:-1] + (1,))
    p_mq = jax.nn.softmax(jnp.concatenate([s_mq, sink_mq], axis=-1), axis=-1)[..., :-1].astype(h.dtype)
    o_m = jnp.einsum('bkgps,bskd->bpkgd', p_mq, v_mq).reshape(B, N_META, N_Q_HEADS * HEAD_DIM)

    return jnp.concatenate([o_m, o_r], axis=1) @ w_o


def multiscale_pool_mixer(h, w_in, w_group, scale, w_out):
    B, L, _ = h.shape
    f32 = jnp.float32
    uf = (h @ w_in).astype(f32).reshape(B, L, N_POOL_GROUPS, POOL_GROUP_DIM)
    cs = jnp.pad(jnp.cumsum(uf, axis=1), ((0, 0), (1, 0), (0, 0), (0, 0)))
    t = jnp.arange(L)
    half = jnp.array(POOL_WINDOWS, dtype=jnp.int32) // 2
    lo = jnp.clip(t[:, None] - half[None, :], 0, L)
    hi = jnp.clip(t[:, None] + half[None, :], 0, L)
    g_idx = jnp.arange(N_POOL_GROUPS)[None, :]
    win_sum = cs[:, hi, g_idx] - cs[:, lo, g_idx]
    mean = win_sum / (hi - lo).astype(f32)[None, :, :, None]
    pooled = (mean - uf).astype(h.dtype)
    mixed = jnp.einsum('blgc,gcd->blgd', pooled, w_group).reshape(B, L, D_MODEL)
    return (mixed * scale) @ w_out


def setup_inputs(seed: int = 0) -> dict:
    key = jax.random.key(seed)
    ks = jax.random.split(key, 16)
    nrm = jax.random.normal
    f32 = jnp.float32
    return {
        'x': nrm(ks[0], (BATCH, SEQ, D_MODEL), f32),
        'meta_tokens': nrm(ks[1], (N_META, D_MODEL), f32),
        'ffn_norm': 1.0 + 0.02 * nrm(ks[2], (DEPTH, 2, D_MODEL), f32),
        'w_gate_up': nrm(ks[3], (DEPTH, 2, D_MODEL, 2 * D_FF), f32) * D_MODEL ** -0.5,
        'w_down': nrm(ks[4], (DEPTH, 2, D_FF, D_MODEL), f32) * D_FF ** -0.5,
        'mixer_norm': 1.0 + 0.02 * nrm(ks[5], (DEPTH, D_MODEL), f32),
        'w_qkv': nrm(ks[6], (N_ATTN_LAYERS, D_MODEL, QKV_DIM), f32) * D_MODEL ** -0.5,
        'q_norm': 1.0 + 0.02 * nrm(ks[7], (N_ATTN_LAYERS, HEAD_DIM), f32),
        'k_norm': 1.0 + 0.02 * nrm(ks[8], (N_ATTN_LAYERS, HEAD_DIM), f32),
        'sink_logit': nrm(ks[9], (N_ATTN_LAYERS, N_Q_HEADS), f32),
        'w_o': nrm(ks[10], (N_ATTN_LAYERS, N_Q_HEADS * HEAD_DIM, D_MODEL), f32) * (N_Q_HEADS * HEAD_DIM) ** -0.5,
        'w_pool_in': nrm(ks[11], (N_POOL_LAYERS, D_MODEL, D_MODEL), f32) * D_MODEL ** -0.5,
        'w_pool_group': nrm(ks[12], (N_POOL_LAYERS, N_POOL_GROUPS, POOL_GROUP_DIM, POOL_GROUP_DIM), f32) * POOL_GROUP_DIM ** -0.5,
        'pool_scale': 1.0 + 0.02 * nrm(ks[13], (N_POOL_LAYERS, D_MODEL), f32),
        'w_pool_out': nrm(ks[14], (N_POOL_LAYERS, D_MODEL, D_MODEL), f32) * D_MODEL ** -0.5,
    }


def reference(x, meta_tokens, ffn_norm, w_gate_up, w_down, mixer_norm, w_qkv, q_norm, k_norm,
              sink_logit, w_o, w_pool_in, w_pool_group, pool_scale, w_pool_out):
    B = x.shape[0]
    meta = jnp.broadcast_to(meta_tokens[None].astype(x.dtype), (B, N_META, D_MODEL))
    h = jnp.concatenate([meta, x], axis=1)
    for i in range(DEPTH):
        h = h + 0.5 * swiglu(rms_norm(h, ffn_norm[i, 0]), w_gate_up[i, 0], w_down[i, 0])
        hn = rms_norm(h, mixer_norm[i])
        j = i // N_MIXERS
        if i % N_MIXERS == 0:
            h = h + windowed_gqa_attention(hn, w_qkv[j], q_norm[j], k_norm[j], sink_logit[j], w_o[j])
        else:
            h = h + multiscale_pool_mixer(hn, w_pool_in[j], w_pool_group[j], pool_scale[j], w_pool_out[j])
        h = h + 0.5 * swiglu(rms_norm(h, ffn_norm[i, 1]), w_gate_up[i, 1], w_down[i, 1])
    return h[:, N_META:]
```

```cpp
#include <hip/hip_runtime.h>
#include <hip/hip_cooperative_groups.h>
#include <cstdio>
#include <cstdint>
namespace cg = cooperative_groups;
#ifndef REV_GU
#define REV_GU 0
#endif
#ifndef REV_DOWN
#define REV_DOWN 1
#endif
#define GSYNC() xcd_barrier(xbar)


namespace pg8 {
#define PG8_LAS __attribute__((address_space(3)))
typedef unsigned short bf16_t;
typedef short bf16x8 __attribute__((ext_vector_type(8)));
typedef float f32x4 __attribute__((ext_vector_type(4)));
typedef unsigned u32x4 __attribute__((ext_vector_type(4)));
typedef unsigned u32x2 __attribute__((ext_vector_type(2)));
constexpr int BM = 256, BK = 64, HALF = 128, HTB = HALF * BK * 2  , STAGE_BYTES = 8 * HTB, NXCD = 8, WGM = 8;

__host__ __device__ __forceinline__ int lds_byte(int r, int c) { const int st = (r >> 4) * 2 + (c >> 5), rr = r & 15, cc = c & 31, ob = rr * 64 + cc * 2; return st * 1024 + (ob ^ (((ob >> 9) & 1) << 5)); }
__host__ __device__ __forceinline__ void stage_rc(int b, int& R, int& C) { const int st = b / 1024, sb = b % 1024, swz = sb ^ (((sb >> 9) & 1) << 5); R = (st >> 1) * 16 + swz / 64; C = (st & 1) * 32 + (swz % 64) / 2; }
__host__ __device__ __forceinline__ int perm32(int rho) { const int n = rho >> 4, i = rho & 15; return 8 * (i >> 2) + 4 * n + (i & 3); }

struct Unit { int pm, pn; };
struct Gemm { const bf16_t* A; const bf16_t* Bt; int M, N, K, lda, a_pn_off; unsigned kstepA; size_t tstepA; };

struct StaticOrder {
    int nM, nN, nwg, G, c, rev;
    __host__ __device__ void init(int M, int N, int G_, int c_, int rev_ = 0) { nM = M / BM; nN = N / BM; nwg = nM * nN; G = G_; c = c_; rev = (rev_ && nwg % G_ == 0) ? 1 : 0; }
    __host__ __device__ bool next(int i, Unit& u) const {
        if (rev) { const int nr = nwg / G; if (i >= nr) return false; i = nr - 1 - i; }
        const long L = (long)i * G + c; if (L >= nwg) return false;
        int wgid = (int)L; { const int q = nwg / NXCD, r = nwg % NXCD, xcd = wgid % NXCD, off = wgid / NXCD; wgid = (xcd < r ? xcd * (q + 1) : r * (q + 1) + (xcd - r) * q) + off; }
        const int nig = WGM * nN, gid = wgid / nig, fm = gid * WGM, gsz = (nM - fm) < WGM ? (nM - fm) : WGM;
        u.pm = fm + ((wgid % nig) % gsz); u.pn = (wgid % nig) / gsz; return true;
    }
    __device__ __forceinline__ void a_ready(const Unit&) const {}
    __device__ __forceinline__ void done(const Unit&) const {}
};

__device__ __forceinline__ unsigned cvt_pk_bf16(float lo, float hi) { unsigned r; asm volatile("v_cvt_pk_bf16_f32 %0, %1, %2" : "=v"(r) : "v"(lo), "v"(hi)); return r; }

constexpr float RMS_EPS = 1e-6f;
typedef unsigned long long ssq_t;
__device__ __forceinline__ void ssq_add(ssq_t* p, float part) { atomicAdd(p, (ssq_t)(part * 16777216.0f)); }
__device__ __forceinline__ ssq_t ssq_fix(float s) { return (ssq_t)(s * 16777216.0f); }
__device__ __forceinline__ float ssq_rs(ssq_t v) { return __builtin_amdgcn_rsqf((float)v * (1.0f / (16777216.0f * 1024.0f)) + RMS_EPS); }

struct EpiGU {
    static constexpr bool PERM = true, AFTER_DRAIN = false;
    bf16_t* O; int ldc; const ssq_t* ssq;
    __device__ __forceinline__ void operator()(const f32x4 (&acc)[2][2][4][2], const Unit& u, int wr, int wc, int fr, int fq) const {
        const int row0 = u.pm * BM + wr * 64 + fr, col0 = u.pn * HALF + wc * 32 + 8 * fq;
        float rsv[2][4]; ssq_t sv[2][4];
#pragma unroll
        for (int ai = 0; ai < 2; ++ai)
#pragma unroll
            for (int m = 0; m < 4; ++m) sv[ai][m] = ssq[row0 + ai * HALF + m * 16];
#pragma unroll
        for (int ai = 0; ai < 2; ++ai)
#pragma unroll
            for (int m = 0; m < 4; ++m) rsv[ai][m] = ssq_rs(sv[ai][m]);
        asm volatile("" ::: "memory");
#pragma unroll
        for (int ai = 0; ai < 2; ++ai)
#pragma unroll
            for (int m = 0; m < 4; ++m) {
                const int row = row0 + ai * HALF + m * 16;
                const float rs = rsv[ai][m], nrs = rs * -1.44269504089f, rs2 = rs * rs;
                typedef float f32x2 __attribute__((ext_vector_type(2)));
                float a[8];
#pragma unroll
                for (int n = 0; n < 2; ++n)
#pragma unroll
                    for (int hf = 0; hf < 2; ++hf) {
                        const f32x2 g2 = (f32x2){acc[ai][0][m][n][2 * hf], acc[ai][0][m][n][2 * hf + 1]}, u2 = (f32x2){acc[ai][1][m][n][2 * hf], acc[ai][1][m][n][2 * hf + 1]};
                        const f32x2 t = g2 * nrs;
                        f32x2 e; e.x = __builtin_amdgcn_exp2f(t.x); e.y = __builtin_amdgcn_exp2f(t.y);
                        const f32x2 d = e + 1.0f;
                        f32x2 r; r.x = __builtin_amdgcn_rcpf(d.x); r.y = __builtin_amdgcn_rcpf(d.y);
                        const f32x2 o = (g2 * u2) * (r * rs2);
                        a[n * 4 + 2 * hf] = o.x; a[n * 4 + 2 * hf + 1] = o.y;
                    }
                u32x4 w; w.x = cvt_pk_bf16(a[0], a[1]); w.y = cvt_pk_bf16(a[2], a[3]); w.z = cvt_pk_bf16(a[4], a[5]); w.w = cvt_pk_bf16(a[6], a[7]);
                *(u32x4*)(O + ((size_t)(u.pm * (ldc >> 6) + (col0 >> 6)) * 256 + (row & 255)) * 64 + (col0 & 63)) = w;
            }
    }
};
struct EpiBf16S {
    static constexpr bool PERM = true, AFTER_DRAIN = false;
    bf16_t* O; int ldc; const ssq_t* ssq;
    __device__ __forceinline__ void operator()(const f32x4 (&acc)[2][2][4][2], const Unit& u, int wr, int wc, int fr, int fq) const {
        const int row0 = u.pm * BM + wr * 64 + fr, col0 = u.pn * BM + wc * 32 + 8 * fq;
        float rsv[2][4];
#pragma unroll
        for (int ai = 0; ai < 2; ++ai)
#pragma unroll
            for (int m = 0; m < 4; ++m) rsv[ai][m] = ssq ? ssq_rs(ssq[row0 + ai * HALF + m * 16]) : 1.0f;
        asm volatile("" ::: "memory");
#pragma unroll
        for (int ai = 0; ai < 2; ++ai)
#pragma unroll
            for (int m = 0; m < 4; ++m) {
                const int row = row0 + ai * HALF + m * 16;
                const float rs = rsv[ai][m];
                bf16_t* rowp = O + (size_t)row * ldc + col0;
#pragma unroll
                for (int bj = 0; bj < 2; ++bj) {
                    const f32x4 v0 = acc[ai][bj][m][0] * rs, v1 = acc[ai][bj][m][1] * rs;
                    u32x4 w; w.x = cvt_pk_bf16(v0[0], v0[1]); w.y = cvt_pk_bf16(v0[2], v0[3]); w.z = cvt_pk_bf16(v1[0], v1[1]); w.w = cvt_pk_bf16(v1[2], v1[3]);
                    *(u32x4*)(rowp + bj * HALF) = w;
                }
            }
    }
};
struct EpiResid {
    static constexpr bool PERM = false, AFTER_DRAIN = false;
    const float* hin32; const float* hin_meta; bf16_t* hb; ssq_t* ssq_out; float* out; float alpha; int final_;
    __device__ __forceinline__ void operator()(const f32x4 (&acc)[2][2][4][2], const Unit& u, int wr, int wc, int fr, int fq) const {
        const int row0 = u.pm * BM + wr * 64 + fr, col0 = u.pn * BM + wc * 32 + 4 * fq;
#pragma unroll
        for (int ai = 0; ai < 2; ++ai) {
            f32x4 v[4][2][2];
            if (hin32) {
#pragma unroll
                for (int m = 0; m < 4; ++m) {
                    const int row = row0 + ai * HALF + m * 16;
                    const float* bp = (hin_meta && row >= 32768) ? hin_meta + (size_t)((row - 32768) & 15) * 1024 + col0 : hin32 + (size_t)row * 1024 + col0;
#pragma unroll
                    for (int bj = 0; bj < 2; ++bj)
#pragma unroll
                        for (int n = 0; n < 2; ++n) v[m][bj][n] = *(const f32x4*)(bp + bj * HALF + n * 16);
                }
            } else {
                u32x2 rw[4][2][2];
#pragma unroll
                for (int m = 0; m < 4; ++m) {
                    const bf16_t* bp = hb + (size_t)(row0 + ai * HALF + m * 16) * 1024 + col0;
#pragma unroll
                    for (int bj = 0; bj < 2; ++bj)
#pragma unroll
                        for (int n = 0; n < 2; ++n) rw[m][bj][n] = *(const u32x2*)(bp + bj * HALF + n * 16);
                }
#pragma unroll
                for (int m = 0; m < 4; ++m)
#pragma unroll
                    for (int bj = 0; bj < 2; ++bj)
#pragma unroll
                        for (int n = 0; n < 2; ++n) { const u32x2 r = rw[m][bj][n];
                            v[m][bj][n] = (f32x4){__builtin_bit_cast(float, r.x << 16), __builtin_bit_cast(float, r.x & 0xffff0000u), __builtin_bit_cast(float, r.y << 16), __builtin_bit_cast(float, r.y & 0xffff0000u)}; }
            }
            asm volatile("" ::: "memory");
#pragma unroll
            for (int m = 0; m < 4; ++m) {
                const int row = row0 + ai * HALF + m * 16;
                const size_t off = (size_t)row * 1024 + col0;
#pragma unroll
                for (int bj = 0; bj < 2; ++bj)
#pragma unroll
                    for (int n = 0; n < 2; ++n) v[m][bj][n] = v[m][bj][n] + acc[ai][bj][m][n] * alpha;
                if (final_) {
                    float* op = out + off;
#pragma unroll
                    for (int bj = 0; bj < 2; ++bj)
#pragma unroll
                        for (int n = 0; n < 2; ++n) *(f32x4*)(op + bj * HALF + n * 16) = v[m][bj][n];
                } else {
                    float part = 0.f;
#pragma unroll
                    for (int bj = 0; bj < 2; ++bj)
#pragma unroll
                        for (int n = 0; n < 2; ++n) {
                            const f32x4 x = v[m][bj][n];
                            u32x2 w; w.x = cvt_pk_bf16(x[0], x[1]); w.y = cvt_pk_bf16(x[2], x[3]);
                            *(u32x2*)(hb + off + bj * HALF + n * 16) = w;
                            part += (x[0] * x[0] + x[1] * x[1]) + (x[2] * x[2] + x[3] * x[3]);
                        }
                    part += __shfl_xor(part, 16); part += __shfl_xor(part, 32);
                    if (fq == 0) ssq_add(ssq_out + row, part);
                }
            }
        }
    }
};

template <class Epi, class Sched, bool ALIGN_EPI = false, bool SP2 = true>
__device__ __forceinline__ void gemm_phase(PG8_LAS unsigned char* lds, const Gemm g, const Sched& S, const Epi& E) {
    int tid_ = threadIdx.x; asm volatile("" : "+v"(tid_));
    const int tid = tid_, wid = __builtin_amdgcn_readfirstlane(tid >> 6), lane = tid & 63, wr = wid >> 2, wc = wid & 3, fr = lane & 15, fq = lane >> 4;
    const int K = g.K, nt = K / BK;
    unsigned voffA[2], voffB[2];
#pragma unroll
    for (int i = 0; i < 2; ++i) { int R, C; stage_rc(tid * 16 + i * 8192, R, C); const int Rb = Epi::PERM ? ((R & ~31) + perm32(R & 31)) : R;
        voffA[i] = (unsigned)(R * g.lda + C) * 2u; voffB[i] = (unsigned)(Rb * K + C) * 2u; }
    const size_t kstep = (size_t)(BK * 2), kstepA = g.kstepA;
    const size_t hstep = (size_t)HALF * K * 2, hstepA = (size_t)HALF * g.lda * 2;
    const size_t tstep = 2 * hstep, tstepA = g.tstepA, pnA = (size_t)g.a_pn_off * 2;
    const unsigned ldsw = (unsigned)wid * 1024u;
    const int aoff = lds_byte(wr * 64 + fr, fq * 8), boff = lds_byte(wc * 32 + fr, fq * 8);
#define PG8_SA(b, h) (((b) * 2 + (h)) * HTB)
#define PG8_SB(b, h) ((4 + (b) * 2 + (h)) * HTB)
#define PG8_STAGE(bufoff, gbase, voff) do { _Pragma("unroll") for (int _i = 0; _i < 2; ++_i) \
        __builtin_amdgcn_global_load_lds((const unsigned*)((const char*)(gbase) + (voff)[_i]), (PG8_LAS unsigned*)(lds + (bufoff) + ldsw + _i * 8192), 16, 0, 0); } while (0)
#define PG8_LDA(dst, b, h) do { _Pragma("unroll") for (int m = 0; m < 4; ++m) _Pragma("unroll") for (int k = 0; k < 2; ++k) dst[m][k] = *(const PG8_LAS bf16x8*)(lds + PG8_SA(b, h) + aoff + m * 2048 + k * 1024); } while (0)
#define PG8_LDB(dst, b, h) do { _Pragma("unroll") for (int n = 0; n < 2; ++n) _Pragma("unroll") for (int k = 0; k < 2; ++k) dst[n][k] = *(const PG8_LAS bf16x8*)(lds + PG8_SB(b, h) + boff + n * 2048 + k * 1024); } while (0)
#define PG8_MMA(ai, bj, At, Bt) do { __builtin_amdgcn_s_setprio(1); _Pragma("unroll") for (int m = 0; m < 4; ++m) _Pragma("unroll") for (int n = 0; n < 2; ++n) _Pragma("unroll") for (int k = 0; k < 2; ++k) \
        acc[ai][bj][m][n] = __builtin_amdgcn_mfma_f32_16x16x32_bf16(Bt[n][k], At[m][k], acc[ai][bj][m][n], 0, 0, 0); __builtin_amdgcn_s_setprio(0); } while (0)
#define PG8_WAIT_V(n) asm volatile("s_waitcnt vmcnt(" #n ")" ::: "memory")
#define PG8_WAIT_L(n) asm volatile("s_waitcnt lgkmcnt(" #n ")" ::: "memory")
#define PG8_BAR __builtin_amdgcn_s_barrier()
#define PG8_SCHED __builtin_amdgcn_sched_barrier(0)
    Unit cur, nxt; int ui = 0;
    if (!S.next(0, cur)) return;
    f32x4 acc[2][2][4][2];
#pragma unroll
    for (int a = 0; a < 2; ++a)
#pragma unroll
        for (int b = 0; b < 2; ++b)
#pragma unroll
            for (int m = 0; m < 4; ++m)
#pragma unroll
                for (int n = 0; n < 2; ++n) acc[a][b][m][n] = (f32x4){0.f, 0.f, 0.f, 0.f};
    bf16x8 At[4][2], B0[2][2], B1[2][2];
    const char* cA = (const char*)g.A + (size_t)cur.pm * tstepA + (size_t)cur.pn * pnA; const char* cB = (const char*)g.Bt + (size_t)cur.pn * tstep;
    S.a_ready(cur);
    if constexpr (SP2) {
        PG8_STAGE(PG8_SB(0, 0), cB, voffB); PG8_STAGE(PG8_SB(0, 1), cB + hstep, voffB); PG8_STAGE(PG8_SA(0, 0), cA, voffA); PG8_STAGE(PG8_SA(0, 1), cA + hstepA, voffA);
        if (wr == 1) PG8_BAR;
        PG8_WAIT_V(2); PG8_BAR;
        PG8_STAGE(PG8_SB(1, 0), cB + kstep, voffB); PG8_STAGE(PG8_SA(1, 0), cA + kstepA, voffA); PG8_STAGE(PG8_SB(1, 1), cB + hstep + kstep, voffB);
        PG8_WAIT_V(6); PG8_BAR;
    } else {
        PG8_STAGE(PG8_SB(0, 0), cB, voffB); PG8_STAGE(PG8_SA(0, 0), cA, voffA); PG8_STAGE(PG8_SB(0, 1), cB + hstep, voffB); PG8_STAGE(PG8_SA(0, 1), cA + hstepA, voffA);
        if (wr == 1) PG8_BAR;
        PG8_WAIT_V(4); PG8_BAR;
        PG8_STAGE(PG8_SB(1, 0), cB + kstep, voffB); PG8_STAGE(PG8_SA(1, 0), cA + kstepA, voffA); PG8_STAGE(PG8_SB(1, 1), cB + hstep + kstep, voffB);
        PG8_WAIT_V(6); PG8_BAR;
    }
    for (;;) {
        const bool has_next = S.next(ui + 1, nxt);
        const char* nA = has_next ? (const char*)g.A + (size_t)nxt.pm * tstepA + (size_t)nxt.pn * pnA : cA; const char* nB = has_next ? (const char*)g.Bt + (size_t)nxt.pn * tstep : cB;
        for (int t = 0; t < nt; t += 2) {
            const bool last = (t == nt - 2);
            const char* a1 = cA + (size_t)(t + 1) * kstepA;
            const char* a2 = last ? nA : cA + (size_t)(t + 2) * kstepA; const char* b2 = last ? nB : cB + (size_t)(t + 2) * kstep;
            const char* a3 = a2 + kstepA; const char* b3 = b2 + kstep;
            if (last && has_next) S.a_ready(nxt);
            if constexpr (SP2) {
            PG8_LDB(B0, 0, 0); PG8_LDB(B1, 0, 1); PG8_SCHED; PG8_LDA(At, 0, 0); PG8_STAGE(PG8_SA(1, 1), a1 + hstepA, voffA);
            PG8_WAIT_V(8); PG8_WAIT_L(0); PG8_BAR; PG8_MMA(0, 0, At, B0); PG8_MMA(0, 1, At, B1); PG8_BAR; PG8_SCHED;
            PG8_LDA(At, 0, 1); PG8_STAGE(PG8_SB(0, 0), b2, voffB); PG8_STAGE(PG8_SB(0, 1), b2 + hstep, voffB); PG8_STAGE(PG8_SA(0, 0), a2, voffA);
            PG8_WAIT_V(8); PG8_WAIT_L(0); PG8_BAR; PG8_MMA(1, 0, At, B0); PG8_MMA(1, 1, At, B1); PG8_BAR; PG8_SCHED;
            PG8_LDB(B0, 1, 0); PG8_LDB(B1, 1, 1); PG8_SCHED; PG8_LDA(At, 1, 0); PG8_STAGE(PG8_SA(0, 1), a2 + hstepA, voffA);
            PG8_WAIT_V(8); PG8_WAIT_L(0); PG8_BAR; PG8_MMA(0, 0, At, B0); PG8_MMA(0, 1, At, B1); PG8_BAR; PG8_SCHED;
            PG8_LDA(At, 1, 1); PG8_STAGE(PG8_SB(1, 0), b3, voffB); PG8_STAGE(PG8_SB(1, 1), b3 + hstep, voffB); PG8_STAGE(PG8_SA(1, 0), a3, voffA);
            PG8_WAIT_V(8); PG8_WAIT_L(0); PG8_BAR; PG8_MMA(1, 0, At, B0); PG8_MMA(1, 1, At, B1); PG8_BAR; PG8_SCHED;
            } else {
            PG8_LDB(B0, 0, 0); PG8_SCHED; PG8_LDA(At, 0, 0); PG8_STAGE(PG8_SA(1, 1), a1 + hstepA, voffA);
            PG8_WAIT_L(8); PG8_BAR; PG8_WAIT_L(0); PG8_MMA(0, 0, At, B0); PG8_BAR; PG8_SCHED;
            PG8_LDB(B1, 0, 1); PG8_STAGE(PG8_SB(0, 0), b2, voffB);
            PG8_BAR; PG8_WAIT_L(0); PG8_MMA(0, 1, At, B1); PG8_BAR;
            PG8_LDA(At, 0, 1); PG8_STAGE(PG8_SA(0, 0), a2, voffA);
            PG8_BAR; PG8_WAIT_L(0); PG8_MMA(1, 0, At, B0); PG8_BAR; PG8_SCHED;
            PG8_STAGE(PG8_SB(0, 1), b2 + hstep, voffB);
            PG8_WAIT_V(6); PG8_BAR; PG8_MMA(1, 1, At, B1); PG8_BAR;
            PG8_LDB(B0, 1, 0); PG8_SCHED; PG8_LDA(At, 1, 0); PG8_STAGE(PG8_SA(0, 1), a2 + hstepA, voffA);
            PG8_WAIT_L(8); PG8_BAR; PG8_WAIT_L(0); PG8_MMA(0, 0, At, B0); PG8_BAR; PG8_SCHED;
            PG8_LDB(B1, 1, 1); PG8_STAGE(PG8_SB(1, 0), b3, voffB);
            PG8_BAR; PG8_WAIT_L(0); PG8_MMA(0, 1, At, B1); PG8_BAR;
            PG8_LDA(At, 1, 1); PG8_STAGE(PG8_SA(1, 0), a3, voffA);
            PG8_BAR; PG8_WAIT_L(0); PG8_MMA(1, 0, At, B0); PG8_BAR; PG8_SCHED;
            PG8_STAGE(PG8_SB(1, 1), b3 + hstep, voffB);
            PG8_WAIT_V(6); PG8_BAR; PG8_MMA(1, 1, At, B1); PG8_BAR;
            }
        }
        if constexpr (ALIGN_EPI) { if (wr == 0) PG8_BAR; }
        if constexpr (!Epi::AFTER_DRAIN) { E(acc, cur, wr, wc, fr, fq); S.done(cur); }
        if (!has_next) break;
#pragma unroll
        for (int a = 0; a < 2; ++a)
#pragma unroll
            for (int b = 0; b < 2; ++b)
#pragma unroll
                for (int m = 0; m < 4; ++m)
#pragma unroll
                    for (int n = 0; n < 2; ++n) acc[a][b][m][n] = (f32x4){0.f, 0.f, 0.f, 0.f};
        cur = nxt; cA = nA; cB = nB; ++ui;
        if constexpr (ALIGN_EPI) { if (wr == 1) PG8_BAR; }
    }
    PG8_WAIT_V(0);
    if constexpr (!ALIGN_EPI) { if (wr == 0) PG8_BAR; }
    PG8_BAR;
    if constexpr (Epi::AFTER_DRAIN) { E.fused(acc, cur, wr, wc, fr, fq, lds, wid, lane); S.done(cur); }
#undef PG8_SA
#undef PG8_SB
#undef PG8_STAGE
#undef PG8_LDA
#undef PG8_LDB
#undef PG8_MMA
#undef PG8_WAIT_V
#undef PG8_WAIT_L
#undef PG8_BAR
#undef PG8_SCHED
}
}

constexpr int D = 1024, BATCH = 16, SEQ = 2048, NMETA = 16, LTOK = SEQ + NMETA  , M = BATCH * LTOK  , MR = BATCH * SEQ  ;
__device__ __forceinline__ int rowof(int b, int pos) { return pos < NMETA ? MR + b * NMETA + pos : b * SEQ + pos - NMETA; }
constexpr int FF = 2816, NGU = 2 * FF, QKVN = 1536;
constexpr float LOG2E = 1.44269504089f;
constexpr size_t MiB = 1u << 20;
constexpr size_t WS_BAR = 0;
constexpr size_t WS_SSQ = 78 * MiB;
constexpr size_t WS_WGU = 2 * MiB;
constexpr size_t WS_WDN = 46 * MiB;
constexpr size_t WS_WQKV = 68 * MiB;
constexpr size_t WS_WO = 71 * MiB;
constexpr size_t WS_WPIN = 73 * MiB;
constexpr size_t WS_WGRP = 75 * MiB;
constexpr size_t WS_WPOUT = 76 * MiB;
constexpr size_t WS_H = 80 * MiB;
constexpr size_t WS_HB = 209 * MiB;
constexpr size_t WS_ACT = 274 * MiB;
constexpr size_t WS_QKV = WS_ACT, WS_O = WS_ACT + 97 * MiB;
constexpr size_t WS_U = WS_ACT, WS_PL = WS_ACT + 65 * MiB, WS_MX = WS_ACT + 130 * MiB;
constexpr size_t WS_END = 470 * MiB;
constexpr int LDS_BYTES = 131072 + 256, XB_LDS_OFF = 131072;

#define LAS __attribute__((address_space(3)))
typedef unsigned short bf16;
typedef unsigned v4u __attribute__((ext_vector_type(4)));
typedef unsigned v2u __attribute__((ext_vector_type(2)));
typedef float f32x4 __attribute__((ext_vector_type(4)));
typedef float f32x16 __attribute__((ext_vector_type(16)));
typedef short bf16x8 __attribute__((ext_vector_type(8)));
#define LDS_WAIT() asm volatile("s_waitcnt lgkmcnt(0)" ::: "memory")
__device__ __forceinline__ unsigned pk2(float lo, float hi) { return pg8::cvt_pk_bf16(lo, hi); }
__device__ __forceinline__ float bflo(unsigned w) { return __builtin_bit_cast(float, w << 16); }
__device__ __forceinline__ float bfhi(unsigned w) { return __builtin_bit_cast(float, w & 0xffff0000u); }

struct Args {
    const float *x, *meta, *ffn_norm, *w_gu, *w_down, *mixer_norm, *w_qkv, *q_norm, *k_norm, *sink, *w_o, *w_pin, *w_grp, *pool_scale, *w_pout;
    float* out; unsigned char* ws;
};

__device__ __forceinline__ void tr_item(const float* W, int ldw, int k0, int n0, const float* kscale, const float* nscale, bf16* WT, int ldk, int dst_row0, LAS float* scr, int lane) {
    f32x4 v[8]; const int lr = lane >> 3, lc = (lane & 7) * 4;
#pragma unroll
    for (int i = 0; i < 8; ++i) v[i] = *(const f32x4*)(W + (size_t)(k0 + 8 * i + lr) * ldw + n0 + lc);
#pragma unroll
    for (int i = 0; i < 8; ++i) { const int kk = 8 * i + lr; const float ks = kscale ? kscale[k0 + kk] : 1.0f; LAS float* d = scr + kk * 33 + lc;
        d[0] = v[i].x * ks; d[1] = v[i].y * ks; d[2] = v[i].z * ks; d[3] = v[i].w * ks; }
    LDS_WAIT(); asm volatile("" ::: "memory");
    const int c = lane & 7;
#pragma unroll
    for (int j = 0; j < 4; ++j) { const int n = (lane >> 3) + 8 * j; const LAS float* s = scr + (8 * c) * 33 + n; const float ns = nscale ? nscale[n0 + n] : 1.0f;
        v4u o; o.x = pk2(s[0 * 33] * ns, s[1 * 33] * ns); o.y = pk2(s[2 * 33] * ns, s[3 * 33] * ns); o.z = pk2(s[4 * 33] * ns, s[5 * 33] * ns); o.w = pk2(s[6 * 33] * ns, s[7 * 33] * ns);
        *(v4u*)(WT + (size_t)(dst_row0 + n) * ldk + k0 + 8 * c) = o; }
    LDS_WAIT(); asm volatile("" ::: "memory");
}
__device__ __forceinline__ float wave_sum(float v) {
#pragma unroll
    for (int o = 1; o < 64; o <<= 1) v += __shfl_xor(v, o);
    return v;
}
__device__ __forceinline__ void prologue(const Args& a, LAS unsigned char* lds, int G, int c) {
    int tid_ = threadIdx.x; asm volatile("" : "+v"(tid_));
    const int tid = tid_, lane = tid & 63, wave = __builtin_amdgcn_readfirstlane(tid >> 6);
    LAS float* scr = (LAS float*)(lds + wave * 8704);
    const int gw = c * 8 + wave, NGW = G * 8;
    unsigned char* ws = a.ws;
    constexpr int I_GU = 16 * 176, I_DN = 44 * 32, I_QKV = 16 * 48, I_SQ = 16 * 32, I_GR = 4 * 8;
    constexpr int NITEMS = 4 * I_GU + 4 * I_DN + I_QKV + 3 * I_SQ + 4 * I_GR;
    for (int it = gw; it < NITEMS; it += NGW) {
        int r = it;
        if (r < 4 * I_GU) { const int idx = r / I_GU; r -= idx * I_GU; const int kb = r / 176, nb = r % 176, n0 = 32 * nb; const int bj = n0 >= FF ? 1 : 0, ff = n0 - bj * FF;
            tr_item(a.w_gu + (size_t)idx * D * NGU, NGU, 64 * kb, n0, a.ffn_norm + idx * D, nullptr, (bf16*)(ws + WS_WGU) + (size_t)idx * NGU * D, D, (ff >> 7) * 256 + bj * 128 + (ff & 127), scr, lane); continue; }
        r -= 4 * I_GU;
        if (r < 4 * I_DN) { const int idx = r / I_DN; r -= idx * I_DN; const int kb = r / 32, nb = r % 32;
            tr_item(a.w_down + (size_t)idx * FF * D, D, 64 * kb, 32 * nb, nullptr, nullptr, (bf16*)(ws + WS_WDN) + (size_t)idx * D * FF, FF, 32 * nb, scr, lane); continue; }
        r -= 4 * I_DN;
        if (r < I_QKV) { const int kb = r / 48, nb = r % 48; tr_item(a.w_qkv, QKVN, 64 * kb, 32 * nb, a.mixer_norm, nullptr, (bf16*)(ws + WS_WQKV), D, 32 * nb, scr, lane); continue; }
        r -= I_QKV;
        if (r < I_SQ) { const int kb = r / 32, nb = r % 32; tr_item(a.w_o, D, 64 * kb, 32 * nb, nullptr, nullptr, (bf16*)(ws + WS_WO), D, 32 * nb, scr, lane); continue; }
        r -= I_SQ;
        if (r < I_SQ) { const int kb = r / 32, nb = r % 32; tr_item(a.w_pin, D, 64 * kb, 32 * nb, a.mixer_norm + D, nullptr, (bf16*)(ws + WS_WPIN), D, 32 * nb, scr, lane); continue; }
        r -= I_SQ;
        if (r < I_SQ) { const int kb = r / 32, nb = r % 32; tr_item(a.w_pout, D, 64 * kb, 32 * nb, nullptr, nullptr, (bf16*)(ws + WS_WPOUT), D, 32 * nb, scr, lane); continue; }
        r -= I_SQ;
        { const int g = r / I_GR; r -= g * I_GR; const int kb = r / 8, nb = r % 8;
          tr_item(a.w_grp + (size_t)g * 65536, 256, 64 * kb, 32 * nb, nullptr, a.pool_scale + g * 256, (bf16*)(ws + WS_WGRP), 256, g * 256 + 32 * nb, scr, lane); }
    }
    bf16* hb = (bf16*)(ws + WS_HB); pg8::ssq_t* ssq = (pg8::ssq_t*)(ws + WS_SSQ);
    for (int m4 = gw; m4 < M / 4; m4 += NGW) {
        f32x4 v[4][4];
#pragma unroll
        for (int r = 0; r < 4; ++r) { const int m = 4 * m4 + r; const float* src = m < MR ? a.x + (size_t)m * D : a.meta + (size_t)((m - MR) & 15) * D;
#pragma unroll
            for (int j = 0; j < 4; ++j) v[r][j] = ((const f32x4*)src)[lane + 64 * j]; }
#pragma unroll
        for (int r = 0; r < 4; ++r) { const int m = 4 * m4 + r; v2u* br = (v2u*)(hb + (size_t)m * D) + lane; float s = 0.f;
#pragma unroll
            for (int j = 0; j < 4; ++j) { const f32x4 x = v[r][j]; v2u w; w.x = pk2(x.x, x.y); w.y = pk2(x.z, x.w); br[64 * j] = w; s += (x.x * x.x + x.y * x.y) + (x.z * x.z + x.w * x.w); }
            s = wave_sum(s);
            if (lane == 0) ssq[m] = pg8::ssq_fix(s); }
    }
    for (int i = c * 512 + tid; i < 5 * M; i += G * 512) ssq[M + i] = 0ull;
}

struct MetaEpi { const pg8::ssq_t* ssq_in; bf16* obf; int ldc; const float* hin_meta; bf16* hb; pg8::ssq_t* ssq_out; float alpha; int dup; };
template <int MODE>
__device__ __forceinline__ void meta_gemm(LAS unsigned char* lds, const bf16* A  , int lda, int kst  , const bf16* Bt, int K, int ncc, const MetaEpi& e, int G, int c) {
    constexpr int NB = MODE == 0 ? 2 : 1, NP = 1 + NB, PSTR = 144, PANEL = 32 * PSTR, WREG = 14336;
    static_assert(NP * PANEL <= WREG && NB * 4096 <= WREG && 8 * WREG <= 131072, "meta LDS");
    int tid_ = threadIdx.x; asm volatile("" : "+v"(tid_));
    const int tid = tid_, lane = tid & 63, wave = __builtin_amdgcn_readfirstlane(tid >> 6), l32 = lane & 31, hh = lane >> 5;
    const int nst = K / 64, s0 = (nst * wave) >> 3, s1 = (nst * (wave + 1)) >> 3;
    LAS unsigned char* wl = lds + wave * WREG;
    const int lrow = lane >> 3, lch = lane & 7;
    const int dup = e.dup, nitems = dup ? ncc : 8 * ncc;
#pragma unroll 1
    for (int item = c; item < nitems; item += G) {
        const int rb = dup ? 0 : (item & 7), cc = dup ? item : (item >> 3);
        const bf16* ag = A + (size_t)(32 * rb + lrow) * lda + lch * 8;
        const bf16* bg[NB];
        if (MODE == 0) { const int ff0 = cc * 32; bg[0] = Bt + (size_t)((ff0 >> 7) * 256 + (ff0 & 127) + lrow) * K + lch * 8; bg[NB - 1] = bg[0] + (size_t)128 * K; }
        else bg[0] = Bt + (size_t)(cc * 32 + lrow) * K + lch * 8;
        f32x16 acc[NB];
#pragma unroll
        for (int p = 0; p < NB; ++p)
#pragma unroll
            for (int i = 0; i < 16; ++i) acc[p][i] = 0.f;
#pragma unroll 1
        for (int s = s0; s < s1; s += 2) {
            const bool two = (s + 1 < s1);
            v4u r[2][NP][4];
#pragma unroll
            for (int t = 0; t < 2; ++t) { const int st = (t == 1 && !two) ? s : s + t;
#pragma unroll
                for (int j = 0; j < 4; ++j) { r[t][0][j] = *(const v4u*)(ag + (size_t)st * kst + (size_t)(8 * j) * lda);
#pragma unroll
                    for (int p = 0; p < NB; ++p) r[t][1 + p][j] = *(const v4u*)(bg[p] + st * 64 + (size_t)(8 * j) * K); } }
#pragma unroll
            for (int t = 0; t < 2; ++t) {
                if (t == 1 && !two) break;
#pragma unroll
                for (int pn = 0; pn < NP; ++pn)
#pragma unroll
                    for (int j = 0; j < 4; ++j) *(LAS v4u*)(wl + pn * PANEL + (8 * j + lrow) * PSTR + lch * 16) = r[t][pn][j];
#pragma unroll
                for (int kk = 0; kk < 4; ++kk) { const bf16x8 af = *(const LAS bf16x8*)(wl + l32 * PSTR + (kk * 16 + hh * 8) * 2);
#pragma unroll
                    for (int p = 0; p < NB; ++p) { const bf16x8 bfr = *(const LAS bf16x8*)(wl + (1 + p) * PANEL + l32 * PSTR + (kk * 16 + hh * 8) * 2);
                        acc[p] = __builtin_amdgcn_mfma_f32_32x32x16_bf16(bfr, af, acc[p], 0, 0, 0); } }
            }
        }
#pragma unroll
        for (int p = 0; p < NB; ++p)
#pragma unroll
            for (int i = 0; i < 16; ++i) *(LAS float*)(wl + ((p * 16 + i) * 64 + lane) * 4) = acc[p][i];
        __syncthreads();
        float v[NB][2];
#pragma unroll
        for (int p = 0; p < NB; ++p) { v[p][0] = 0.f; v[p][1] = 0.f; }
#pragma unroll
        for (int w = 0; w < 8; ++w)
#pragma unroll
            for (int p = 0; p < NB; ++p)
#pragma unroll
                for (int q = 0; q < 2; ++q) v[p][q] += *(const LAS float*)(lds + w * WREG + ((p * 16 + 2 * wave + q) * 64 + lane) * 4);
        const int i0 = 2 * wave, col = cc * 32 + (i0 & 3) + 8 * (i0 >> 2) + 4 * hh, nrep = dup ? 8 : 1;
#pragma unroll 1
        for (int r8 = 0; r8 < nrep; ++r8) {
        const int row = MR + 32 * (rb + r8) + l32;
        if (MODE == 0) {
            const float rs = pg8::ssq_rs(e.ssq_in[row]); float av[2];
#pragma unroll
            for (int q = 0; q < 2; ++q) { const float gv = v[0][q] * rs, uv = v[NB - 1][q] * rs; av[q] = gv * __builtin_amdgcn_rcpf(1.0f + __builtin_amdgcn_exp2f(gv * -1.44269504089f)) * uv; }
            *(unsigned*)(e.obf + ((size_t)(128 * (e.ldc >> 6) + (col >> 6)) * 256 + (row - MR)) * 64 + (col & 63)) = pk2(av[0], av[1]);
        } else if (MODE == 1) {
            const float rs = pg8::ssq_rs(e.ssq_in[row]);
            *(unsigned*)(e.obf + (size_t)row * e.ldc + col) = pk2(v[0][0] * rs, v[0][1] * rs);
        } else {
            typedef float f32x2 __attribute__((ext_vector_type(2)));
            const size_t off = (size_t)row * D + col;
            f32x2 x;
            if (e.hin_meta) x = *(const f32x2*)(e.hin_meta + (size_t)((row - MR) & 15) * D + col);
            else { const unsigned r = *(const unsigned*)(e.hb + off); x.x = bflo(r); x.y = bfhi(r); }
            x.x += e.alpha * v[0][0]; x.y += e.alpha * v[0][1];
            *(unsigned*)(e.hb + off) = pk2(x.x, x.y);
            float part = x.x * x.x + x.y * x.y; part += __shfl_xor(part, 32);
            if (hh == 0) pg8::ssq_add(e.ssq_out + row, part);
        }
        }
        __syncthreads();
    }
}

constexpr int KSTR = 144, NSLOTP = 416, VSTR = 840, K_OFF = 0, V_OFF = NSLOTP * KSTR;
static_assert(V_OFF + 64 * VSTR <= 131072, "attention LDS");
constexpr int ATT_UNITS = BATCH * 4 * 16 + BATCH * 4;

__device__ __forceinline__ void attn_phase(LAS unsigned char* lds, const bf16* qkv, bf16* o, const float* qg, const float* kg, const float* sink, int G, int c) {
    int tid_ = threadIdx.x; asm volatile("" : "+v"(tid_));
    const int tid = tid_, lane = tid & 63, wave = __builtin_amdgcn_readfirstlane(tid >> 6), l32 = lane & 31, hh = lane >> 5;
    float kgmax = __builtin_fabsf(kg[lane]);
#pragma unroll
    for (int o = 1; o < 64; o <<= 1) kgmax = fmaxf(kgmax, __shfl_xor(kgmax, o));
    kgmax = __builtin_bit_cast(float, __builtin_amdgcn_readfirstlane(__builtin_bit_cast(int, kgmax)));
#pragma unroll 1
    for (int it = 0;; ++it) {
        int b, kh, j; bool meta, first;
        if (G == 256) {
            const int y = c >> 3;
            if (it < 4) { const int P = (c & 7) * 8 + (y >> 2); b = P >> 2; kh = P & 3; j = (y & 3) * 4 + it; meta = false; first = (it == 0); }
            else if (it == 4 && y < 8) { const int P = (c & 7) * 8 + y; b = P >> 2; kh = P & 3; j = 0; meta = true; first = true; }
            else break;
        } else {
            const int uidx = c + it * G; if (uidx >= ATT_UNITS) break;
            if (uidx < 1024) { b = uidx >> 6; kh = (uidx >> 4) & 3; j = uidx & 15; meta = false; } else { const int r = uidx - 1024; b = r >> 2; kh = r & 3; j = 0; meta = true; }
            first = true;
        }
        const int Blo = meta ? 0 : (j > 0 ? j - 1 : 0), Bhi = meta ? 0 : (j < 15 ? j + 1 : 15);
        const int qb = meta ? 0 : (wave & 3), hp = meta ? (wave & 1) : (wave >> 2);
        const int qlo = meta ? 0 : NMETA + 128 * j + 32 * qb, qhi = meta ? 15 : qlo + 31;
        const int qpos = meta ? (l32 & 15) : qlo + l32;
        const int head0 = kh * 4 + 2 * hp;
        v4u kr[7], vr[7];
#pragma unroll
        for (int i = 0; i < 7; ++i) {
            const int part = tid & 7, o = tid >> 3;
            kr[i] = (v4u){0u, 0u, 0u, 0u}; vr[i] = (v4u){0u, 0u, 0u, 0u};
            int pos = -1;
            if (i < 6) { const int Bc = (meta ? 0 : j - 1) + (i >> 1); if (Bc >= Blo && Bc <= Bhi && (first || Bc == j + 1) && !(meta && i >= 2)) pos = NMETA + 128 * Bc + 64 * (i & 1) + o; }
            else if (first && o < NMETA) pos = o;
            if (pos >= 0) { const bf16* rp = qkv + (size_t)rowof(b, pos) * QKVN + kh * 64 + part * 8; kr[i] = *(const v4u*)(rp + 1024); vr[i] = *(const v4u*)(rp + 1280); }
        }
        v4u qraw[2][4];
#pragma unroll
        for (int h = 0; h < 2; ++h) { const bf16* qp = qkv + (size_t)rowof(b, qpos) * QKVN + (head0 + h) * 64 + hh * 8;
#pragma unroll
            for (int kk = 0; kk < 4; ++kk) qraw[h][kk] = *(const v4u*)(qp + kk * 16); }
        __syncthreads();
#pragma unroll
        for (int i = 0; i < 7; ++i) {
            const int part = tid & 7, o = tid >> 3;
            int slot = -1;
            if (i < 6) { const int Bc = (meta ? 0 : j - 1) + (i >> 1); if (Bc >= Blo && Bc <= Bhi && (first || Bc == j + 1) && !(meta && i >= 2)) slot = (Bc % 3) * 128 + 64 * (i & 1) + o; }
            else if (first && o < 32) slot = 384 + o;
            const v4u kw = kr[i], vw = vr[i];
            float kf[8] = {bflo(kw.x), bfhi(kw.x), bflo(kw.y), bfhi(kw.y), bflo(kw.z), bfhi(kw.z), bflo(kw.w), bfhi(kw.w)};
            float ss = 0.f;
#pragma unroll
            for (int e = 0; e < 8; ++e) ss += kf[e] * kf[e];
            ss += __shfl_xor(ss, 1); ss += __shfl_xor(ss, 2); ss += __shfl_xor(ss, 4);
            const float rs = __builtin_amdgcn_rsqf(ss * (1.0f / 64.0f) + pg8::RMS_EPS);
            const f32x4 g0 = *(const f32x4*)(kg + part * 8), g1 = *(const f32x4*)(kg + part * 8 + 4);
            v4u kp; kp.x = pk2(kf[0] * rs * g0.x, kf[1] * rs * g0.y); kp.y = pk2(kf[2] * rs * g0.z, kf[3] * rs * g0.w);
            kp.z = pk2(kf[4] * rs * g1.x, kf[5] * rs * g1.y); kp.w = pk2(kf[6] * rs * g1.z, kf[7] * rs * g1.w);
            if (slot >= 0) {
                *(LAS v4u*)(lds + K_OFF + slot * KSTR + part * 16) = kp;
                LAS unsigned char* vb = lds + V_OFF + (part * 8) * VSTR + slot * 2;
                *(LAS unsigned short*)(vb + 0 * VSTR) = (unsigned short)(vw.x & 0xffffu); *(LAS unsigned short*)(vb + 1 * VSTR) = (unsigned short)(vw.x >> 16);
                *(LAS unsigned short*)(vb + 2 * VSTR) = (unsigned short)(vw.y & 0xffffu); *(LAS unsigned short*)(vb + 3 * VSTR) = (unsigned short)(vw.y >> 16);
                *(LAS unsigned short*)(vb + 4 * VSTR) = (unsigned short)(vw.z & 0xffffu); *(LAS unsigned short*)(vb + 5 * VSTR) = (unsigned short)(vw.z >> 16);
                *(LAS unsigned short*)(vb + 6 * VSTR) = (unsigned short)(vw.w & 0xffffu); *(LAS unsigned short*)(vb + 7 * VSTR) = (unsigned short)(vw.w >> 16);
            }
        }
        bf16x8 qf[2][4]; float slope2[2], sink2[2], mfix[2];
#pragma unroll
        for (int h = 0; h < 2; ++h) {
            float ss = 0.f;
#pragma unroll
            for (int kk = 0; kk < 4; ++kk) { const v4u w = qraw[h][kk];
                const float f0 = bflo(w.x), f1 = bfhi(w.x), f2 = bflo(w.y), f3 = bfhi(w.y), f4 = bflo(w.z), f5 = bfhi(w.z), f6 = bflo(w.w), f7 = bfhi(w.w);
                ss += (f0 * f0 + f1 * f1) + (f2 * f2 + f3 * f3) + (f4 * f4 + f5 * f5) + (f6 * f6 + f7 * f7); }
            ss += __shfl_xor(ss, 32);
            const float rs = __builtin_amdgcn_rsqf(ss * (1.0f / 64.0f) + pg8::RMS_EPS) * (0.125f * LOG2E);
            float qn2 = 0.f;
#pragma unroll
            for (int kk = 0; kk < 4; ++kk) { const f32x4 g0 = *(const f32x4*)(qg + kk * 16 + hh * 8), g1 = *(const f32x4*)(qg + kk * 16 + hh * 8 + 4); const v4u r = qraw[h][kk];
                const float q0 = bflo(r.x) * rs * g0.x, q1 = bfhi(r.x) * rs * g0.y, q2 = bflo(r.y) * rs * g0.z, q3 = bfhi(r.y) * rs * g0.w;
                const float q4 = bflo(r.z) * rs * g1.x, q5 = bfhi(r.z) * rs * g1.y, q6 = bflo(r.w) * rs * g1.z, q7 = bfhi(r.w) * rs * g1.w;
                qn2 += (q0 * q0 + q1 * q1) + (q2 * q2 + q3 * q3) + (q4 * q4 + q5 * q5) + (q6 * q6 + q7 * q7);
                v4u w; w.x = pk2(q0, q1); w.y = pk2(q2, q3); w.z = pk2(q4, q5); w.w = pk2(q6, q7);
                qf[h][kk] = __builtin_bit_cast(bf16x8, w); }
            qn2 += __shfl_xor(qn2, 32);
            mfix[h] = __builtin_sqrtf(qn2) * (8.0f * kgmax);
            slope2[h] = __builtin_bit_cast(float, __builtin_amdgcn_readfirstlane(__builtin_bit_cast(int, __builtin_amdgcn_exp2f(-0.5f * (float)(head0 + h + 1)) * LOG2E)));
            sink2[h] = __builtin_bit_cast(float, __builtin_amdgcn_readfirstlane(__builtin_bit_cast(int, sink[head0 + h] * LOG2E)));
        }
        __syncthreads();
        if (meta && wave >= 2) continue;
        f32x16 oacc[2][2];
#pragma unroll
        for (int h = 0; h < 2; ++h)
#pragma unroll
            for (int d = 0; d < 2; ++d)
#pragma unroll
                for (int i = 0; i < 16; ++i) oacc[h][d][i] = 0.f;
        float lrun[2] = {0.f, 0.f};
#pragma unroll 1
        for (int kb = 0; kb < 13; ++kb) {
            int plo = 0;
            if (kb < 12) {
                const int rp = kb >> 2;
                const int Bq = meta ? (rp == 0 ? 0 : -1) : (j - 1) + ((rp + 3 - (j + 2) % 3) % 3);
                if (Bq < Blo || Bq > Bhi) continue;
                plo = NMETA + 128 * Bq + 32 * (kb & 3);
                if (plo + 31 < qlo - 128 || plo > qhi + 128) continue;
            }
            const int phi = plo + 31;
            const bool full = kb < 12, inwin = plo >= qhi - 128 && phi <= qlo + 128;
            const float dqf = (float)(qpos - (plo + 4 * hh));
            bf16x8 pf[2][2];
#pragma unroll
            for (int h = 0; h < 2; ++h) {
                const float nsl = -slope2[h], m0 = -mfix[h];
                f32x16 s;
#pragma unroll
                for (int i = 0; i < 16; ++i) s[i] = m0;
#pragma unroll
                for (int kk = 0; kk < 4; ++kk) { const bf16x8 kfr = *(const LAS bf16x8*)(lds + K_OFF + (32 * kb + l32) * KSTR + (kk * 16 + hh * 8) * 2);
                    s = __builtin_amdgcn_mfma_f32_32x32x16_bf16(kfr, qf[h][kk], s, 0, 0, 0); }
                asm volatile("" ::: "memory");
                if (full) {
                    if (inwin) {
#pragma unroll
                        for (int i = 0; i < 16; ++i) s[i] = __builtin_fmaf(nsl, __builtin_fabsf(dqf - (float)(8 * (i >> 2) + (i & 3))), s[i]);
                    } else {
#pragma unroll
                        for (int i = 0; i < 16; ++i) { const float df = __builtin_fabsf(dqf - (float)(8 * (i >> 2) + (i & 3)));
                            const float v = __builtin_fmaf(nsl, df, s[i]); s[i] = df <= 128.0f ? v : -1e30f; }
                    }
                } else {
#pragma unroll
                    for (int i = 0; i < 16; ++i) {
                        const int mk = 8 * (i >> 2) + 4 * hh + (i & 3);
                        int dist = qpos - mk; dist = dist < 0 ? -dist : dist;
                        const bool ok = mk < NMETA;
                        s[i] = ok ? __builtin_fmaf(nsl, (float)dist, s[i]) : -1e30f;
                    }
                }
                float ps = 0.f;
#pragma unroll
                for (int i = 0; i < 16; ++i) { const float p = __builtin_amdgcn_exp2f(s[i]); s[i] = p; ps += p; }
                lrun[h] += ps;
#pragma unroll
                for (int jj = 0; jj < 2; ++jj) { v4u w; w.x = pk2(s[8 * jj + 0], s[8 * jj + 1]); w.y = pk2(s[8 * jj + 2], s[8 * jj + 3]);
                    w.z = pk2(s[8 * jj + 4], s[8 * jj + 5]); w.w = pk2(s[8 * jj + 6], s[8 * jj + 7]); pf[h][jj] = __builtin_bit_cast(bf16x8, w); }
            }
#pragma unroll
            for (int d = 0; d < 2; ++d)
#pragma unroll
                for (int jj = 0; jj < 2; ++jj) {
                    const LAS unsigned char* vb = lds + V_OFF + (32 * d + l32) * VSTR + (32 * kb + 16 * jj + 4 * hh) * 2;
                    const v2u lo = *(const LAS v2u*)vb, hi = *(const LAS v2u*)(vb + 16);
                    const bf16x8 vf = __builtin_bit_cast(bf16x8, (v4u){lo.x, lo.y, hi.x, hi.y});
#pragma unroll
                    for (int h = 0; h < 2; ++h) oacc[h][d] = __builtin_amdgcn_mfma_f32_32x32x16_bf16(vf, pf[h][jj], oacc[h][d], 0, 0, 0);
                }
        }
        const bool st = !meta || l32 < 16;
#pragma unroll
        for (int h = 0; h < 2; ++h) {
            const float lt = lrun[h] + __shfl_xor(lrun[h], 32) + __builtin_amdgcn_exp2f(sink2[h] - mfix[h]);
            const float inv = 1.0f / lt;
            bf16* op = o + (size_t)rowof(b, qpos) * D + (head0 + h) * 64 + 8 * hh;
#pragma unroll
            for (int d = 0; d < 2; ++d)
#pragma unroll
                for (int kp = 0; kp < 2; ++kp) {
                    const int i0 = 8 * kp, i1 = 8 * kp + 4;
                    unsigned ax = pk2(oacc[h][d][i0 + 0] * inv, oacc[h][d][i0 + 1] * inv), ay = pk2(oacc[h][d][i0 + 2] * inv, oacc[h][d][i0 + 3] * inv);
                    unsigned bx = pk2(oacc[h][d][i1 + 0] * inv, oacc[h][d][i1 + 1] * inv), by = pk2(oacc[h][d][i1 + 2] * inv, oacc[h][d][i1 + 3] * inv);
                    const auto rx = __builtin_amdgcn_permlane32_swap(ax, bx, false, false); ax = rx[0]; bx = rx[1];
                    const auto ry = __builtin_amdgcn_permlane32_swap(ay, by, false, false); ay = ry[0]; by = ry[1];
                    if (st) *(v4u*)(op + 32 * d + 16 * kp) = (v4u){ax, ay, bx, by};
                }
        }
    }
}

template <int H>
__device__ __forceinline__ void pool_run(const bf16* u, bf16* pl, int b, int l0, int cc) {
    v4u rw[2 * H + 3];
#pragma unroll
    for (int k = 0; k < 2 * H + 3; ++k) { const int s = l0 - H + k; rw[k] = (v4u){0u, 0u, 0u, 0u};
        if (s >= 0 && s < LTOK) rw[k] = *(const v4u*)(u + (size_t)rowof(b, s) * D + cc * 8); }
    float acc[8] = {0.f, 0.f, 0.f, 0.f, 0.f, 0.f, 0.f, 0.f};
#define POOL_ADD(k, sg) do { const v4u w_ = rw[k]; acc[0] += sg bflo(w_.x); acc[1] += sg bfhi(w_.x); acc[2] += sg bflo(w_.y); acc[3] += sg bfhi(w_.y); \
        acc[4] += sg bflo(w_.z); acc[5] += sg bfhi(w_.z); acc[6] += sg bflo(w_.w); acc[7] += sg bfhi(w_.w); } while (0)
#pragma unroll
    for (int k = 0; k < 2 * H; ++k) POOL_ADD(k, +);
#pragma unroll
    for (int j = 0; j < 4; ++j) {
        const int l = l0 + j;
        if (j > 0) { POOL_ADD(j - 1, -); POOL_ADD(j + 2 * H - 1, +); }
        const int lo = l - H > 0 ? l - H : 0, hi = l + H < LTOK ? l + H : LTOK;
        const float inv = 1.0f / (float)(hi - lo);
        const v4u w = rw[j + H];
        v4u ov; ov.x = pk2(acc[0] * inv - bflo(w.x), acc[1] * inv - bfhi(w.x)); ov.y = pk2(acc[2] * inv - bflo(w.y), acc[3] * inv - bfhi(w.y));
        ov.z = pk2(acc[4] * inv - bflo(w.z), acc[5] * inv - bfhi(w.z)); ov.w = pk2(acc[6] * inv - bflo(w.w), acc[7] * inv - bfhi(w.w));
        *(v4u*)(pl + (size_t)rowof(b, l) * D + cc * 8) = ov;
    }
#undef POOL_ADD
}
__device__ __forceinline__ void pool_phase(const bf16* u, bf16* pl, int G, int c) {
    int tid_ = threadIdx.x; asm volatile("" : "+v"(tid_));
    const int tid = tid_;
    for (int it = c * 512 + tid; it < BATCH * 4 * 512 * 32; it += G * 512) {
        const int cl = it & 31, r = (it >> 5) & 511, grp = (it >> 14) & 3, b = it >> 16;
        const int cc = grp * 32 + cl, l0 = NMETA + 4 * r;
        if (grp == 0) pool_run<1>(u, pl, b, l0, cc); else if (grp == 1) pool_run<2>(u, pl, b, l0, cc); else if (grp == 2) pool_run<4>(u, pl, b, l0, cc); else pool_run<8>(u, pl, b, l0, cc);
    }
}

#define XB_TMO      128
#define XB_XCNT(j)  (256  + 64 * (j))
#define XB_XSUB(j)  (1280 + 64 * (j))
#define XB_XGEN(j)  (2304 + 64 * (j))
#define XB_TOP      3328
#define XB_TOPGEN   3392
#define XCD_BAR_WORDS 3456
#define XB_SPIN_CAP (1u << 18)

__device__ __forceinline__ unsigned xb_ld(unsigned* p)              { return __hip_atomic_load(p, __ATOMIC_RELAXED, __HIP_MEMORY_SCOPE_AGENT); }
__device__ __forceinline__ unsigned xb_add(unsigned* p, unsigned v) { return __hip_atomic_fetch_add(p, v, __ATOMIC_RELAXED, __HIP_MEMORY_SCOPE_AGENT); }
__device__ __forceinline__ unsigned xb_xcc_id() { return (unsigned)__builtin_amdgcn_s_getreg((3 << 11) | 20) & 0xFu; }
#define XB_SPIN(cond, bar) do { unsigned _sp = 0; while (cond) { __builtin_amdgcn_s_sleep(1); \
    if ((++_sp & 255u) == 0u) { if (xb_ld(&(bar)[XB_TMO])) break; if (_sp > XB_SPIN_CAP) { atomicAdd(&(bar)[XB_TMO], 1u); break; } } } } while (0)

struct XcdBarrier {
    unsigned* bar; unsigned x;
    volatile LAS unsigned* st;
};

__device__ __forceinline__ XcdBarrier xcd_barrier_post(unsigned* bar, volatile LAS unsigned* st) {
    XcdBarrier b; b.bar = bar; b.x = xb_xcc_id(); b.st = st;
    if (threadIdx.x == 0) (void)xb_add(&bar[XB_XCNT(b.x)], 1u);
    return b;
}
__device__ __forceinline__ void xcd_barrier_complete(unsigned* bar, unsigned x, unsigned& nloc, unsigned& nx) {
    const unsigned G = gridDim.x * gridDim.y * gridDim.z;
    unsigned sum, cnt, mine, sp = 0u;
    for (;;) {
        sum = 0u; cnt = 0u; mine = 0u;
#pragma unroll
        for (unsigned j = 0; j < 16; ++j) { const unsigned c = xb_ld(&bar[XB_XCNT(j)]); sum += c; cnt += (c > 0u) ? 1u : 0u; mine = (j == x) ? c : mine; }
        if (sum == G) break;
        __builtin_amdgcn_s_sleep(1);
        if ((++sp & 255u) == 0u) { if (xb_ld(&bar[XB_TMO])) break; if (sp > XB_SPIN_CAP) { atomicAdd(&bar[XB_TMO], 1u); break; } }
    }
    nloc = mine > 0u ? mine : 1u; nx = cnt > 0u ? cnt : 1u;
}

__device__ __forceinline__ void xcd_barrier(const XcdBarrier& b) {
    asm volatile("s_waitcnt vmcnt(0)" ::: "memory");
    __syncthreads();
    if (threadIdx.x == 0) {
        unsigned* bar = b.bar;
        __builtin_amdgcn_s_waitcnt(0);
        unsigned nloc = b.st[0], nx = b.st[1];
        if (nloc == 0u) { xcd_barrier_complete(bar, b.x, nloc, nx); b.st[0] = nloc; b.st[1] = nx; }
        const unsigned old = xb_add(&bar[XB_XSUB(b.x)], 1u);
        const unsigned gen = old / nloc;
        if (old + 1u == (gen + 1u) * nloc) {
            __builtin_amdgcn_fence(__ATOMIC_RELEASE, "agent");
            asm volatile("s_waitcnt vmcnt(0)" ::: "memory");
            const unsigned og = xb_add(&bar[XB_TOP], 1u);
            const unsigned tg = og / nx;
            if (og + 1u == (tg + 1u) * nx) xb_add(&bar[XB_TOPGEN], 1u);
            else XB_SPIN(xb_ld(&bar[XB_TOPGEN]) == tg, bar);
            __builtin_amdgcn_fence(__ATOMIC_ACQUIRE, "agent");
            xb_add(&bar[XB_XGEN(b.x)], 1u);
            asm volatile("s_waitcnt vmcnt(0)" ::: "memory");
        } else {
            XB_SPIN(xb_ld(&bar[XB_XGEN(b.x)]) == gen, bar);
            __builtin_amdgcn_fence(__ATOMIC_ACQUIRE, "agent");
            asm volatile("s_waitcnt vmcnt(0)" ::: "memory");
        }
    }
    __syncthreads();
}

__global__ void __launch_bounds__(512, 2) fwd_megakernel(Args a) {
    extern __shared__ __attribute__((aligned(16))) unsigned char lds_raw[];
    LAS unsigned char* lds = (LAS unsigned char*)lds_raw;
    cg::grid_group grid = cg::this_grid();
    const int G = gridDim.x, c = blockIdx.x;
    unsigned char* ws = a.ws;
    bf16* hb = (bf16*)(ws + WS_HB); pg8::ssq_t* ssq = (pg8::ssq_t*)(ws + WS_SSQ); bf16* act = (bf16*)(ws + WS_ACT);

    if (c == 0) { unsigned* bw = (unsigned*)(ws + WS_BAR); for (int i = threadIdx.x; i < XCD_BAR_WORDS; i += 512) bw[i] = 0u; }
    if (threadIdx.x < 2) ((volatile LAS unsigned*)(lds + XB_LDS_OFF))[threadIdx.x] = 0u;
    prologue(a, lds, G, c);
    grid.sync();
    const XcdBarrier xbar = xcd_barrier_post((unsigned*)(ws + WS_BAR), (volatile LAS unsigned*)(lds + XB_LDS_OFF));

    int np = 0;
#pragma unroll 1
    for (int f = 0; f < 4; ++f) {
        {
            if (f < 3) { const MetaEpi me{ssq + (size_t)np * M, act, FF, nullptr, nullptr, nullptr, 0.f, f == 0 ? 1 : 0};
                meta_gemm<0>(lds, hb + (size_t)MR * D, D, 64, (const bf16*)(ws + WS_WGU) + (size_t)f * NGU * D, D, FF / 32, me, G, c); }
            pg8::Gemm g{hb, (const bf16*)(ws + WS_WGU) + (size_t)f * NGU * D, MR, NGU, D, D, 0, 128u, (size_t)256 * D * 2}; pg8::StaticOrder S; S.init(MR, NGU, G, c, REV_GU);
            pg8::EpiGU E{act, FF, ssq + (size_t)np * M};
            pg8::gemm_phase<pg8::EpiGU, pg8::StaticOrder, true, true>(lds, g, S, E);
        }
        GSYNC();
        {
            if (f < 3) { const MetaEpi me{nullptr, nullptr, 0, f == 0 ? a.meta : nullptr, hb, ssq + (size_t)(np + 1) * M, 0.5f, f == 0 ? 1 : 0};
                meta_gemm<2>(lds, act + (size_t)128 * (FF / 64) * 16384, 64, 16384, (const bf16*)(ws + WS_WDN) + (size_t)f * D * FF, FF, D / 32, me, G, c); }
            pg8::Gemm g{act, (const bf16*)(ws + WS_WDN) + (size_t)f * D * FF, MR, D, FF, 64, 0, 32768u, (size_t)(FF / 64) * 32768}; pg8::StaticOrder S; S.init(MR, D, G, c, REV_DOWN);
            pg8::EpiResid E{f == 0 ? a.x : nullptr, f == 0 ? a.meta : nullptr, hb, ssq + (size_t)(np + 1) * M, a.out, 0.5f, f == 3 ? 1 : 0};
            pg8::gemm_phase<pg8::EpiResid, pg8::StaticOrder, true, true>(lds, g, S, E);
        }
        ++np;
        if (f == 3) break;
        GSYNC();
        if (f == 0 || f == 2) {
            const bool is_attn = (f == 0);
            {
                const int N = is_attn ? QKVN : D;
                { const MetaEpi me{ssq + (size_t)np * M, (bf16*)(ws + WS_ACT), N, nullptr, nullptr, nullptr, 0.f, is_attn ? 1 : 0};
                  meta_gemm<1>(lds, hb + (size_t)MR * D, D, 64, (const bf16*)(ws + (is_attn ? WS_WQKV : WS_WPIN)), D, N / 32, me, G, c); }
                pg8::Gemm g{hb, (const bf16*)(ws + (is_attn ? WS_WQKV : WS_WPIN)), MR, N, D, D, 0, 128u, (size_t)256 * D * 2}; pg8::StaticOrder S; S.init(MR, N, G, c);
                pg8::EpiBf16S E{(bf16*)(ws + WS_ACT), N, ssq + (size_t)np * M};
                pg8::gemm_phase<pg8::EpiBf16S, pg8::StaticOrder, true, true>(lds, g, S, E);
            }
            GSYNC();
            if (is_attn) {
                attn_phase(lds, (const bf16*)(ws + WS_QKV), (bf16*)(ws + WS_O), a.q_norm, a.k_norm, a.sink, G, c);
                __syncthreads();
            } else {
                pool_phase((const bf16*)(ws + WS_U), (bf16*)(ws + WS_PL), G, c);
                GSYNC();
                {
                    pg8::Gemm g{(const bf16*)(ws + WS_PL), (const bf16*)(ws + WS_WGRP), MR, D, 256, D, 256, 128u, (size_t)256 * D * 2}; pg8::StaticOrder S; S.init(MR, D, G, c);
                    pg8::EpiBf16S E{(bf16*)(ws + WS_MX), D, nullptr};
                    pg8::gemm_phase<pg8::EpiBf16S, pg8::StaticOrder, true, true>(lds, g, S, E);
                }
            }
            GSYNC();
            {
                if (is_attn) { const MetaEpi me{nullptr, nullptr, 0, nullptr, hb, ssq + (size_t)(np + 1) * M, 1.0f, 0};
                    meta_gemm<2>(lds, (const bf16*)(ws + WS_O) + (size_t)MR * D, D, 64, (const bf16*)(ws + WS_WO), D, D / 32, me, G, c); }
                pg8::Gemm g{(const bf16*)(ws + (is_attn ? WS_O : WS_MX)), (const bf16*)(ws + (is_attn ? WS_WO : WS_WPOUT)), MR, D, D, D, 0, 128u, (size_t)256 * D * 2}; pg8::StaticOrder S; S.init(MR, D, G, c);
                pg8::EpiResid E{nullptr, nullptr, hb, ssq + (size_t)(np + 1) * M, a.out, 1.0f, 0};
                pg8::gemm_phase<pg8::EpiResid, pg8::StaticOrder, true, true>(lds, g, S, E);
            }
            ++np;
            GSYNC();
        }
    }
}

extern "C" void kernel_launch(void* const* d_in, const int* in_sizes, int n_in, void* d_out, int out_size, void* d_ws, size_t ws_size, hipStream_t stream) {
    static int grid = 0;
    if (grid == 0) {
        if (n_in != 15 || ws_size < WS_END) { fprintf(stderr, "kernel_launch: expected 15 inputs and >= %zu bytes of workspace (got %d, %zu)\n", (size_t)WS_END, n_in, ws_size); grid = -1; return; }
        int dev = 0, cus = 0, per_cu = 0;
        hipGetDevice(&dev); hipDeviceGetAttribute(&cus, hipDeviceAttributeMultiprocessorCount, dev);
        if (hipFuncSetAttribute((const void*)fwd_megakernel, hipFuncAttributeMaxDynamicSharedMemorySize, LDS_BYTES) != hipSuccess) { fprintf(stderr, "kernel_launch: hipFuncSetAttribute failed\n"); grid = -1; return; }
        if (hipOccupancyMaxActiveBlocksPerMultiprocessor(&per_cu, (const void*)fwd_megakernel, 512, LDS_BYTES) != hipSuccess || per_cu < 1) { fprintf(stderr, "kernel_launch: occupancy query says %d blocks per CU\n", per_cu); per_cu = 1; }
        (void)hipGetLastError();
        grid = cus * 1;
    }
    if (grid < 0) return;
    Args a{};
    a.x = (const float*)d_in[0]; a.meta = (const float*)d_in[1]; a.ffn_norm = (const float*)d_in[2]; a.w_gu = (const float*)d_in[3]; a.w_down = (const float*)d_in[4];
    a.mixer_norm = (const float*)d_in[5]; a.w_qkv = (const float*)d_in[6]; a.q_norm = (const float*)d_in[7]; a.k_norm = (const float*)d_in[8]; a.sink = (const float*)d_in[9];
    a.w_o = (const float*)d_in[10]; a.w_pin = (const float*)d_in[11]; a.w_grp = (const float*)d_in[12]; a.pool_scale = (const float*)d_in[13]; a.w_pout = (const float*)d_in[14];
    a.out = (float*)d_out; a.ws = (unsigned char*)d_ws;
    void* args[] = {&a};
    hipError_t e = hipLaunchCooperativeKernel((const void*)fwd_megakernel, dim3(grid), dim3(512), args, LDS_BYTES, stream);
    if (e != hipSuccess) fprintf(stderr, "kernel_launch: cooperative launch failed: %s (grid %d)\n", hipGetErrorString(e), grid);
}
```

```cpp
#include <hip/hip_runtime.h>
#include <hip/hip_cooperative_groups.h>
#include <cstdio>
#include <cstdint>
namespace cg = cooperative_groups;
#ifndef REV_GU
#define REV_GU 0
#endif
#ifndef REV_DOWN
#define REV_DOWN 1
#endif
#define GSYNC() xcd_barrier(xbar)


namespace pg8 {
#define PG8_LAS __attribute__((address_space(3)))
typedef unsigned short bf16_t;
typedef short bf16x8 __attribute__((ext_vector_type(8)));
typedef float f32x4 __attribute__((ext_vector_type(4)));
typedef unsigned u32x4 __attribute__((ext_vector_type(4)));
typedef unsigned u32x2 __attribute__((ext_vector_type(2)));
constexpr int BM = 256, BK = 64, HALF = 128, HTB = HALF * BK * 2  , STAGE_BYTES = 8 * HTB, NXCD = 8, WGM = 8;

__host__ __device__ __forceinline__ int lds_byte(int r, int c) { const int st = (r >> 4) * 2 + (c >> 5), rr = r & 15, cc = c & 31, ob = rr * 64 + cc * 2; return st * 1024 + (ob ^ (((ob >> 9) & 1) << 5)); }
__host__ __device__ __forceinline__ void stage_rc(int b, int& R, int& C) { const int st = b / 1024, sb = b % 1024, swz = sb ^ (((sb >> 9) & 1) << 5); R = (st >> 1) * 16 + swz / 64; C = (st & 1) * 32 + (swz % 64) / 2; }
__host__ __device__ __forceinline__ int perm32(int rho) { const int n = rho >> 4, i = rho & 15; return 8 * (i >> 2) + 4 * n + (i & 3); }

struct Unit { int pm, pn; };
struct Gemm { const bf16_t* A; const bf16_t* Bt; int M, N, K, lda, a_pn_off; unsigned kstepA; size_t tstepA; };

struct StaticOrder {
    int nM, nN, nwg, G, c, rev;
    __host__ __device__ void init(int M, int N, int G_, int c_, int rev_ = 0) { nM = M / BM; nN = N / BM; nwg = nM * nN; G = G_; c = c_; rev = (rev_ && nwg % G_ == 0) ? 1 : 0; }
    __host__ __device__ bool next(int i, Unit& u) const {
        if (rev) { const int nr = nwg / G; if (i >= nr) return false; i = nr - 1 - i; }
        const long L = (long)i * G + c; if (L >= nwg) return false;
        int wgid = (int)L; { const int q = nwg / NXCD, r = nwg % NXCD, xcd = wgid % NXCD, off = wgid / NXCD; wgid = (xcd < r ? xcd * (q + 1) : r * (q + 1) + (xcd - r) * q) + off; }
        const int nig = WGM * nN, gid = wgid / nig, fm = gid * WGM, gsz = (nM - fm) < WGM ? (nM - fm) : WGM;
        u.pm = fm + ((wgid % nig) % gsz); u.pn = (wgid % nig) / gsz; return true;
    }
    __device__ __forceinline__ void a_ready(const Unit&) const {}
    __device__ __forceinline__ void done(const Unit&) const {}
};

__device__ __forceinline__ unsigned cvt_pk_bf16(float lo, float hi) { unsigned r; asm volatile("v_cvt_pk_bf16_f32 %0, %1, %2" : "=v"(r) : "v"(lo), "v"(hi)); return r; }

constexpr float RMS_EPS = 1e-6f;
typedef unsigned long long ssq_t;
__device__ __forceinline__ void ssq_add(ssq_t* p, float part) { atomicAdd(p, (ssq_t)(part * 16777216.0f)); }
__device__ __forceinline__ ssq_t ssq_fix(float s) { return (ssq_t)(s * 16777216.0f); }
__device__ __forceinline__ float ssq_rs(ssq_t v) { return __builtin_amdgcn_rsqf((float)v * (1.0f / (16777216.0f * 1024.0f)) + RMS_EPS); }

struct EpiGU {
    static constexpr bool PERM = true, AFTER_DRAIN = false;
    bf16_t* O; int ldc; const ssq_t* ssq;
    __device__ __forceinline__ void operator()(const f32x4 (&acc)[2][2][4][2], const Unit& u, int wr, int wc, int fr, int fq) const {
        const int row0 = u.pm * BM + wr * 64 + fr, col0 = u.pn * HALF + wc * 32 + 8 * fq;
        float rsv[2][4]; ssq_t sv[2][4];
#pragma unroll
        for (int ai = 0; ai < 2; ++ai)
#pragma unroll
            for (int m = 0; m < 4; ++m) sv[ai][m] = ssq[row0 + ai * HALF + m * 16];
#pragma unroll
        for (int ai = 0; ai < 2; ++ai)
#pragma unroll
            for (int m = 0; m < 4; ++m) rsv[ai][m] = ssq_rs(sv[ai][m]);
        asm volatile("" ::: "memory");
#pragma unroll
        for (int ai = 0; ai < 2; ++ai)
#pragma unroll
            for (int m = 0; m < 4; ++m) {
                const int row = row0 + ai * HALF + m * 16;
                const float rs = rsv[ai][m], nrs = rs * -1.44269504089f, rs2 = rs * rs;
                typedef float f32x2 __attribute__((ext_vector_type(2)));
                float a[8];
#pragma unroll
                for (int n = 0; n < 2; ++n)
#pragma unroll
                    for (int hf = 0; hf < 2; ++hf) {
                        const f32x2 g2 = (f32x2){acc[ai][0][m][n][2 * hf], acc[ai][0][m][n][2 * hf + 1]}, u2 = (f32x2){acc[ai][1][m][n][2 * hf], acc[ai][1][m][n][2 * hf + 1]};
                        const f32x2 t = g2 * nrs;
                        f32x2 e; e.x = __builtin_amdgcn_exp2f(t.x); e.y = __builtin_amdgcn_exp2f(t.y);
                        const f32x2 d = e + 1.0f;
                        f32x2 r; r.x = __builtin_amdgcn_rcpf(d.x); r.y = __builtin_amdgcn_rcpf(d.y);
                        const f32x2 o = (g2 * u2) * (r * rs2);
                        a[n * 4 + 2 * hf] = o.x; a[n * 4 + 2 * hf + 1] = o.y;
                    }
                u32x4 w; w.x = cvt_pk_bf16(a[0], a[1]); w.y = cvt_pk_bf16(a[2], a[3]); w.z = cvt_pk_bf16(a[4], a[5]); w.w = cvt_pk_bf16(a[6], a[7]);
                __builtin_nontemporal_store(w, (u32x4*)(O + ((size_t)(u.pm * (ldc >> 6) + (col0 >> 6)) * 256 + (row & 255)) * 64 + (col0 & 63)));
            }
    }
};
struct EpiBf16S {
    static constexpr bool PERM = true, AFTER_DRAIN = false;
    bf16_t* O; int ldc; const ssq_t* ssq;
    __device__ __forceinline__ void operator()(const f32x4 (&acc)[2][2][4][2], const Unit& u, int wr, int wc, int fr, int fq) const {
        const int row0 = u.pm * BM + wr * 64 + fr, col0 = u.pn * BM + wc * 32 + 8 * fq;
        float rsv[2][4];
#pragma unroll
        for (int ai = 0; ai < 2; ++ai)
#pragma unroll
            for (int m = 0; m < 4; ++m) rsv[ai][m] = ssq ? ssq_rs(ssq[row0 + ai * HALF + m * 16]) : 1.0f;
        asm volatile("" ::: "memory");
#pragma unroll
        for (int ai = 0; ai < 2; ++ai)
#pragma unroll
            for (int m = 0; m < 4; ++m) {
                const int row = row0 + ai * HALF + m * 16;
                const float rs = rsv[ai][m];
                bf16_t* rowp = O + (size_t)row * ldc + col0;
#pragma unroll
                for (int bj = 0; bj < 2; ++bj) {
                    const f32x4 v0 = acc[ai][bj][m][0] * rs, v1 = acc[ai][bj][m][1] * rs;
                    u32x4 w; w.x = cvt_pk_bf16(v0[0], v0[1]); w.y = cvt_pk_bf16(v0[2], v0[3]); w.z = cvt_pk_bf16(v1[0], v1[1]); w.w = cvt_pk_bf16(v1[2], v1[3]);
                    *(u32x4*)(rowp + bj * HALF) = w;
                }
            }
    }
};
struct EpiResid {
    static constexpr bool PERM = false, AFTER_DRAIN = false;
    const float* hin32; const float* hin_meta; bf16_t* hb; ssq_t* ssq_out; float* out; float alpha; int final_;
    __device__ __forceinline__ void operator()(const f32x4 (&acc)[2][2][4][2], const Unit& u, int wr, int wc, int fr, int fq) const {
        const int row0 = u.pm * BM + wr * 64 + fr, col0 = u.pn * BM + wc * 32 + 4 * fq;
#pragma unroll
        for (int ai = 0; ai < 2; ++ai) {
            f32x4 v[4][2][2];
            if (hin32) {
#pragma unroll
                for (int m = 0; m < 4; ++m) {
                    const int row = row0 + ai * HALF + m * 16;
                    const float* bp = (hin_meta && row >= 32768) ? hin_meta + (size_t)((row - 32768) & 15) * 1024 + col0 : hin32 + (size_t)row * 1024 + col0;
#pragma unroll
                    for (int bj = 0; bj < 2; ++bj)
#pragma unroll
                        for (int n = 0; n < 2; ++n) v[m][bj][n] = *(const f32x4*)(bp + bj * HALF + n * 16);
                }
            } else {
                u32x2 rw[4][2][2];
#pragma unroll
                for (int m = 0; m < 4; ++m) {
                    const bf16_t* bp = hb + (size_t)(row0 + ai * HALF + m * 16) * 1024 + col0;
#pragma unroll
                    for (int bj = 0; bj < 2; ++bj)
#pragma unroll
                        for (int n = 0; n < 2; ++n) rw[m][bj][n] = *(const u32x2*)(bp + bj * HALF + n * 16);
                }
#pragma unroll
                for (int m = 0; m < 4; ++m)
#pragma unroll
                    for (int bj = 0; bj < 2; ++bj)
#pragma unroll
                        for (int n = 0; n < 2; ++n) { const u32x2 r = rw[m][bj][n];
                            v[m][bj][n] = (f32x4){__builtin_bit_cast(float, r.x << 16), __builtin_bit_cast(float, r.x & 0xffff0000u), __builtin_bit_cast(float, r.y << 16), __builtin_bit_cast(float, r.y & 0xffff0000u)}; }
            }
            asm volatile("" ::: "memory");
#pragma unroll
            for (int m = 0; m < 4; ++m) {
                const int row = row0 + ai * HALF + m * 16;
                const size_t off = (size_t)row * 1024 + col0;
#pragma unroll
                for (int bj = 0; bj < 2; ++bj)
#pragma unroll
                    for (int n = 0; n < 2; ++n) v[m][bj][n] = v[m][bj][n] + acc[ai][bj][m][n] * alpha;
                if (final_) {
                    float* op = out + off;
#pragma unroll
                    for (int bj = 0; bj < 2; ++bj)
#pragma unroll
                        for (int n = 0; n < 2; ++n) *(f32x4*)(op + bj * HALF + n * 16) = v[m][bj][n];
                } else {
                    float part = 0.f;
#pragma unroll
                    for (int bj = 0; bj < 2; ++bj)
#pragma unroll
                        for (int n = 0; n < 2; ++n) {
                            const f32x4 x = v[m][bj][n];
                            u32x2 w; w.x = cvt_pk_bf16(x[0], x[1]); w.y = cvt_pk_bf16(x[2], x[3]);
                            *(u32x2*)(hb + off + bj * HALF + n * 16) = w;
                            part += (x[0] * x[0] + x[1] * x[1]) + (x[2] * x[2] + x[3] * x[3]);
                        }
                    part += __shfl_xor(part, 16); part += __shfl_xor(part, 32);
                    if (fq == 0) ssq_add(ssq_out + row, part);
                }
            }
        }
    }
};

template <class Epi, class Sched, bool ALIGN_EPI = false, bool SP2 = true>
__device__ __forceinline__ void gemm_phase(PG8_LAS unsigned char* lds, const Gemm g, const Sched& S, const Epi& E) {
    int tid_ = threadIdx.x; asm volatile("" : "+v"(tid_));
    const int tid = tid_, wid = __builtin_amdgcn_readfirstlane(tid >> 6), lane = tid & 63, wr = wid >> 2, wc = wid & 3, fr = lane & 15, fq = lane >> 4;
    const int K = g.K, nt = K / BK;
    unsigned voffA[2], voffB[2];
#pragma unroll
    for (int i = 0; i < 2; ++i) { int R, C; stage_rc(tid * 16 + i * 8192, R, C); const int Rb = Epi::PERM ? ((R & ~31) + perm32(R & 31)) : R;
        voffA[i] = (unsigned)(R * g.lda + C) * 2u; voffB[i] = (unsigned)(Rb * K + C) * 2u; }
    const size_t kstep = (size_t)(BK * 2), kstepA = g.kstepA;
    const size_t hstep = (size_t)HALF * K * 2, hstepA = (size_t)HALF * g.lda * 2;
    const size_t tstep = 2 * hstep, tstepA = g.tstepA, pnA = (size_t)g.a_pn_off * 2;
    const unsigned ldsw = (unsigned)wid * 1024u;
    const int aoff = lds_byte(wr * 64 + fr, fq * 8), boff = lds_byte(wc * 32 + fr, fq * 8);
#define PG8_SA(b, h) (((b) * 2 + (h)) * HTB)
#define PG8_SB(b, h) ((4 + (b) * 2 + (h)) * HTB)
#define PG8_STAGE(bufoff, gbase, voff) do { _Pragma("unroll") for (int _i = 0; _i < 2; ++_i) \
        __builtin_amdgcn_global_load_lds((const unsigned*)((const char*)(gbase) + (voff)[_i]), (PG8_LAS unsigned*)(lds + (bufoff) + ldsw + _i * 8192), 16, 0, 0); } while (0)
#define PG8_LDA(dst, b, h) do { _Pragma("unroll") for (int m = 0; m < 4; ++m) _Pragma("unroll") for (int k = 0; k < 2; ++k) dst[m][k] = *(const PG8_LAS bf16x8*)(lds + PG8_SA(b, h) + aoff + m * 2048 + k * 1024); } while (0)
#define PG8_LDB(dst, b, h) do { _Pragma("unroll") for (int n = 0; n < 2; ++n) _Pragma("unroll") for (int k = 0; k < 2; ++k) dst[n][k] = *(const PG8_LAS bf16x8*)(lds + PG8_SB(b, h) + boff + n * 2048 + k * 1024); } while (0)
#define PG8_MMA(ai, bj, At, Bt) do { __builtin_amdgcn_s_setprio(1); _Pragma("unroll") for (int m = 0; m < 4; ++m) _Pragma("unroll") for (int n = 0; n < 2; ++n) _Pragma("unroll") for (int k = 0; k < 2; ++k) \
        acc[ai][bj][m][n] = __builtin_amdgcn_mfma_f32_16x16x32_bf16(Bt[n][k], At[m][k], acc[ai][bj][m][n], 0, 0, 0); __builtin_amdgcn_s_setprio(0); } while (0)
#define PG8_WAIT_V(n) asm volatile("s_waitcnt vmcnt(" #n ")" ::: "memory")
#define PG8_WAIT_L(n) asm volatile("s_waitcnt lgkmcnt(" #n ")" ::: "memory")
#define PG8_BAR __builtin_amdgcn_s_barrier()
#define PG8_SCHED __builtin_amdgcn_sched_barrier(0)
    Unit cur, nxt; int ui = 0;
    if (!S.next(0, cur)) return;
    f32x4 acc[2][2][4][2];
#pragma unroll
    for (int a = 0; a < 2; ++a)
#pragma unroll
        for (int b = 0; b < 2; ++b)
#pragma unroll
            for (int m = 0; m < 4; ++m)
#pragma unroll
                for (int n = 0; n < 2; ++n) acc[a][b][m][n] = (f32x4){0.f, 0.f, 0.f, 0.f};
    bf16x8 At[4][2], B0[2][2], B1[2][2];
    const char* cA = (const char*)g.A + (size_t)cur.pm * tstepA + (size_t)cur.pn * pnA; const char* cB = (const char*)g.Bt + (size_t)cur.pn * tstep;
    S.a_ready(cur);
    if constexpr (SP2) {
        PG8_STAGE(PG8_SB(0, 0), cB, voffB); PG8_STAGE(PG8_SB(0, 1), cB + hstep, voffB); PG8_STAGE(PG8_SA(0, 0), cA, voffA); PG8_STAGE(PG8_SA(0, 1), cA + hstepA, voffA);
        if (wr == 1) PG8_BAR;
        PG8_WAIT_V(2); PG8_BAR;
        PG8_STAGE(PG8_SB(1, 0), cB + kstep, voffB); PG8_STAGE(PG8_SA(1, 0), cA + kstepA, voffA); PG8_STAGE(PG8_SB(1, 1), cB + hstep + kstep, voffB);
        PG8_WAIT_V(6); PG8_BAR;
    } else {
        PG8_STAGE(PG8_SB(0, 0), cB, voffB); PG8_STAGE(PG8_SA(0, 0), cA, voffA); PG8_STAGE(PG8_SB(0, 1), cB + hstep, voffB); PG8_STAGE(PG8_SA(0, 1), cA + hstepA, voffA);
        if (wr == 1) PG8_BAR;
        PG8_WAIT_V(4); PG8_BAR;
        PG8_STAGE(PG8_SB(1, 0), cB + kstep, voffB); PG8_STAGE(PG8_SA(1, 0), cA + kstepA, voffA); PG8_STAGE(PG8_SB(1, 1), cB + hstep + kstep, voffB);
        PG8_WAIT_V(6); PG8_BAR;
    }
    for (;;) {
        const bool has_next = S.next(ui + 1, nxt);
        const char* nA = has_next ? (const char*)g.A + (size_t)nxt.pm * tstepA + (size_t)nxt.pn * pnA : cA; const char* nB = has_next ? (const char*)g.Bt + (size_t)nxt.pn * tstep : cB;
        for (int t = 0; t < nt; t += 2) {
            const bool last = (t == nt - 2);
            const char* a1 = cA + (size_t)(t + 1) * kstepA;
            const char* a2 = last ? nA : cA + (size_t)(t + 2) * kstepA; const char* b2 = last ? nB : cB + (size_t)(t + 2) * kstep;
            const char* a3 = a2 + kstepA; const char* b3 = b2 + kstep;
            if (last && has_next) S.a_ready(nxt);
            if constexpr (SP2) {
            PG8_LDB(B0, 0, 0); PG8_LDB(B1, 0, 1); PG8_SCHED; PG8_LDA(At, 0, 0); PG8_STAGE(PG8_SA(1, 1), a1 + hstepA, voffA);
            PG8_WAIT_V(8); PG8_WAIT_L(0); PG8_BAR; PG8_MMA(0, 0, At, B0); PG8_MMA(0, 1, At, B1); PG8_BAR; PG8_SCHED;
            PG8_LDA(At, 0, 1); PG8_STAGE(PG8_SB(0, 0), b2, voffB); PG8_STAGE(PG8_SB(0, 1), b2 + hstep, voffB); PG8_STAGE(PG8_SA(0, 0), a2, voffA);
            PG8_WAIT_V(8); PG8_WAIT_L(0); PG8_BAR; PG8_MMA(1, 0, At, B0); PG8_MMA(1, 1, At, B1); PG8_BAR; PG8_SCHED;
            PG8_LDB(B0, 1, 0); PG8_LDB(B1, 1, 1); PG8_SCHED; PG8_LDA(At, 1, 0); PG8_STAGE(PG8_SA(0, 1), a2 + hstepA, voffA);
            PG8_WAIT_V(8); PG8_WAIT_L(0); PG8_BAR; PG8_MMA(0, 0, At, B0); PG8_MMA(0, 1, At, B1); PG8_BAR; PG8_SCHED;
            PG8_LDA(At, 1, 1); PG8_STAGE(PG8_SB(1, 0), b3, voffB); PG8_STAGE(PG8_SB(1, 1), b3 + hstep, voffB); PG8_STAGE(PG8_SA(1, 0), a3, voffA);
            PG8_WAIT_V(8); PG8_WAIT_L(0); PG8_BAR; PG8_MMA(1, 0, At, B0); PG8_MMA(1, 1, At, B1); PG8_BAR; PG8_SCHED;
            } else {
            PG8_LDB(B0, 0, 0); PG8_SCHED; PG8_LDA(At, 0, 0); PG8_STAGE(PG8_SA(1, 1), a1 + hstepA, voffA);
            PG8_WAIT_L(8); PG8_BAR; PG8_WAIT_L(0); PG8_MMA(0, 0, At, B0); PG8_BAR; PG8_SCHED;
            PG8_LDB(B1, 0, 1); PG8_STAGE(PG8_SB(0, 0), b2, voffB);
            PG8_BAR; PG8_WAIT_L(0); PG8_MMA(0, 1, At, B1); PG8_BAR;
            PG8_LDA(At, 0, 1); PG8_STAGE(PG8_SA(0, 0), a2, voffA);
            PG8_BAR; PG8_WAIT_L(0); PG8_MMA(1, 0, At, B0); PG8_BAR; PG8_SCHED;
            PG8_STAGE(PG8_SB(0, 1), b2 + hstep, voffB);
            PG8_WAIT_V(6); PG8_BAR; PG8_MMA(1, 1, At, B1); PG8_BAR;
            PG8_LDB(B0, 1, 0); PG8_SCHED; PG8_LDA(At, 1, 0); PG8_STAGE(PG8_SA(0, 1), a2 + hstepA, voffA);
            PG8_WAIT_L(8); PG8_BAR; PG8_WAIT_L(0); PG8_MMA(0, 0, At, B0); PG8_BAR; PG8_SCHED;
            PG8_LDB(B1, 1, 1); PG8_STAGE(PG8_SB(1, 0), b3, voffB);
            PG8_BAR; PG8_WAIT_L(0); PG8_MMA(0, 1, At, B1); PG8_BAR;
            PG8_LDA(At, 1, 1); PG8_STAGE(PG8_SA(1, 0), a3, voffA);
            PG8_BAR; PG8_WAIT_L(0); PG8_MMA(1, 0, At, B0); PG8_BAR; PG8_SCHED;
            PG8_STAGE(PG8_SB(1, 1), b3 + hstep, voffB);
            PG8_WAIT_V(6); PG8_BAR; PG8_MMA(1, 1, At, B1); PG8_BAR;
            }
        }
        if constexpr (ALIGN_EPI) { if (wr == 0) PG8_BAR; }
        if constexpr (!Epi::AFTER_DRAIN) { E(acc, cur, wr, wc, fr, fq); S.done(cur); }
        if (!has_next) break;
#pragma unroll
        for (int a = 0; a < 2; ++a)
#pragma unroll
            for (int b = 0; b < 2; ++b)
#pragma unroll
                for (int m = 0; m < 4; ++m)
#pragma unroll
                    for (int n = 0; n < 2; ++n) acc[a][b][m][n] = (f32x4){0.f, 0.f, 0.f, 0.f};
        cur = nxt; cA = nA; cB = nB; ++ui;
        if constexpr (ALIGN_EPI) { if (wr == 1) PG8_BAR; }
    }
    PG8_WAIT_V(0);
    if constexpr (!ALIGN_EPI) { if (wr == 0) PG8_BAR; }
    PG8_BAR;
    if constexpr (Epi::AFTER_DRAIN) { E.fused(acc, cur, wr, wc, fr, fq, lds, wid, lane); S.done(cur); }
#undef PG8_SA
#undef PG8_SB
#undef PG8_STAGE
#undef PG8_LDA
#undef PG8_LDB
#undef PG8_MMA
#undef PG8_WAIT_V
#undef PG8_WAIT_L
#undef PG8_BAR
#undef PG8_SCHED
}
}

constexpr int D = 1024, BATCH = 16, SEQ = 2048, NMETA = 16, LTOK = SEQ + NMETA  , M = BATCH * LTOK  , MR = BATCH * SEQ  ;
__device__ __forceinline__ int rowof(int b, int pos) { return pos < NMETA ? MR + b * NMETA + pos : b * SEQ + pos - NMETA; }
constexpr int FF = 2816, NGU = 2 * FF, QKVN = 1536;
constexpr float LOG2E = 1.44269504089f;
constexpr size_t MiB = 1u << 20;
constexpr size_t WS_BAR = 0;
constexpr size_t WS_SSQ = 78 * MiB;
constexpr size_t WS_WGU = 2 * MiB;
constexpr size_t WS_WDN = 46 * MiB;
constexpr size_t WS_WQKV = 68 * MiB;
constexpr size_t WS_WO = 71 * MiB;
constexpr size_t WS_WPIN = 73 * MiB;
constexpr size_t WS_WGRP = 75 * MiB;
constexpr size_t WS_WPOUT = 76 * MiB;
constexpr size_t WS_H = 80 * MiB;
constexpr size_t WS_HB = 209 * MiB;
constexpr size_t WS_ACT = 274 * MiB;
constexpr size_t WS_QKV = WS_ACT, WS_O = WS_ACT + 97 * MiB;
constexpr size_t WS_U = WS_ACT, WS_PL = WS_ACT + 65 * MiB, WS_MX = WS_ACT + 130 * MiB;
constexpr size_t WS_END = 470 * MiB;
constexpr int LDS_BYTES = 131072 + 256, XB_LDS_OFF = 131072;

#define LAS __attribute__((address_space(3)))
typedef unsigned short bf16;
typedef unsigned v4u __attribute__((ext_vector_type(4)));
typedef unsigned v2u __attribute__((ext_vector_type(2)));
typedef float f32x4 __attribute__((ext_vector_type(4)));
typedef float f32x16 __attribute__((ext_vector_type(16)));
typedef short bf16x8 __attribute__((ext_vector_type(8)));
#define LDS_WAIT() asm volatile("s_waitcnt lgkmcnt(0)" ::: "memory")
__device__ __forceinline__ unsigned pk2(float lo, float hi) { return pg8::cvt_pk_bf16(lo, hi); }
__device__ __forceinline__ float bflo(unsigned w) { return __builtin_bit_cast(float, w << 16); }
__device__ __forceinline__ float bfhi(unsigned w) { return __builtin_bit_cast(float, w & 0xffff0000u); }

struct Args {
    const float *x, *meta, *ffn_norm, *w_gu, *w_down, *mixer_norm, *w_qkv, *q_norm, *k_norm, *sink, *w_o, *w_pin, *w_grp, *pool_scale, *w_pout;
    float* out; unsigned char* ws;
};

__device__ __forceinline__ void tr_item(const float* W, int ldw, int k0, int n0, const float* kscale, const float* nscale, bf16* WT, int ldk, int dst_row0, LAS float* scr, int lane) {
    f32x4 v[8]; const int lr = lane >> 3, lc = (lane & 7) * 4;
#pragma unroll
    for (int i = 0; i < 8; ++i) v[i] = *(const f32x4*)(W + (size_t)(k0 + 8 * i + lr) * ldw + n0 + lc);
#pragma unroll
    for (int i = 0; i < 8; ++i) { const int kk = 8 * i + lr; const float ks = kscale ? kscale[k0 + kk] : 1.0f; LAS float* d = scr + kk * 33 + lc;
        d[0] = v[i].x * ks; d[1] = v[i].y * ks; d[2] = v[i].z * ks; d[3] = v[i].w * ks; }
    LDS_WAIT(); asm volatile("" ::: "memory");
    const int c = lane & 7;
#pragma unroll
    for (int j = 0; j < 4; ++j) { const int n = (lane >> 3) + 8 * j; const LAS float* s = scr + (8 * c) * 33 + n; const float ns = nscale ? nscale[n0 + n] : 1.0f;
        v4u o; o.x = pk2(s[0 * 33] * ns, s[1 * 33] * ns); o.y = pk2(s[2 * 33] * ns, s[3 * 33] * ns); o.z = pk2(s[4 * 33] * ns, s[5 * 33] * ns); o.w = pk2(s[6 * 33] * ns, s[7 * 33] * ns);
        *(v4u*)(WT + (size_t)(dst_row0 + n) * ldk + k0 + 8 * c) = o; }
    LDS_WAIT(); asm volatile("" ::: "memory");
}
__device__ __forceinline__ float wave_sum(float v) {
#pragma unroll
    for (int o = 1; o < 64; o <<= 1) v += __shfl_xor(v, o);
    return v;
}
__device__ __forceinline__ void prologue(const Args& a, LAS unsigned char* lds, int G, int c) {
    int tid_ = threadIdx.x; asm volatile("" : "+v"(tid_));
    const int tid = tid_, lane = tid & 63, wave = __builtin_amdgcn_readfirstlane(tid >> 6);
    LAS float* scr = (LAS float*)(lds + wave * 8704);
    const int gw = c * 8 + wave, NGW = G * 8;
    unsigned char* ws = a.ws;
    constexpr int I_GU = 16 * 176, I_DN = 44 * 32, I_QKV = 16 * 48, I_SQ = 16 * 32, I_GR = 4 * 8;
    constexpr int NITEMS = 4 * I_GU + 4 * I_DN + I_QKV + 3 * I_SQ + 4 * I_GR;
    for (int it = gw; it < NITEMS; it += NGW) {
        int r = it;
        if (r < 4 * I_GU) { const int idx = r / I_GU; r -= idx * I_GU; const int kb = r / 176, nb = r % 176, n0 = 32 * nb; const int bj = n0 >= FF ? 1 : 0, ff = n0 - bj * FF;
            tr_item(a.w_gu + (size_t)idx * D * NGU, NGU, 64 * kb, n0, a.ffn_norm + idx * D, nullptr, (bf16*)(ws + WS_WGU) + (size_t)idx * NGU * D, D, (ff >> 7) * 256 + bj * 128 + (ff & 127), scr, lane); continue; }
        r -= 4 * I_GU;
        if (r < 4 * I_DN) { const int idx = r / I_DN; r -= idx * I_DN; const int kb = r / 32, nb = r % 32;
            tr_item(a.w_down + (size_t)idx * FF * D, D, 64 * kb, 32 * nb, nullptr, nullptr, (bf16*)(ws + WS_WDN) + (size_t)idx * D * FF, FF, 32 * nb, scr, lane); continue; }
        r -= 4 * I_DN;
        if (r < I_QKV) { const int kb = r / 48, nb = r % 48; tr_item(a.w_qkv, QKVN, 64 * kb, 32 * nb, a.mixer_norm, nullptr, (bf16*)(ws + WS_WQKV), D, 32 * nb, scr, lane); continue; }
        r -= I_QKV;
        if (r < I_SQ) { const int kb = r / 32, nb = r % 32; tr_item(a.w_o, D, 64 * kb, 32 * nb, nullptr, nullptr, (bf16*)(ws + WS_WO), D, 32 * nb, scr, lane); continue; }
        r -= I_SQ;
        if (r < I_SQ) { const int kb = r / 32, nb = r % 32; tr_item(a.w_pin, D, 64 * kb, 32 * nb, a.mixer_norm + D, nullptr, (bf16*)(ws + WS_WPIN), D, 32 * nb, scr, lane); continue; }
        r -= I_SQ;
        if (r < I_SQ) { const int kb = r / 32, nb = r % 32; tr_item(a.w_pout, D, 64 * kb, 32 * nb, nullptr, nullptr, (bf16*)(ws + WS_WPOUT), D, 32 * nb, scr, lane); continue; }
        r -= I_SQ;
        { const int g = r / I_GR; r -= g * I_GR; const int kb = r / 8, nb = r % 8;
          tr_item(a.w_grp + (size_t)g * 65536, 256, 64 * kb, 32 * nb, nullptr, a.pool_scale + g * 256, (bf16*)(ws + WS_WGRP), 256, g * 256 + 32 * nb, scr, lane); }
    }
    bf16* hb = (bf16*)(ws + WS_HB); pg8::ssq_t* ssq = (pg8::ssq_t*)(ws + WS_SSQ);
    for (int m4 = gw; m4 < M / 4; m4 += NGW) {
        f32x4 v[4][4];
#pragma unroll
        for (int r = 0; r < 4; ++r) { const int m = 4 * m4 + r; const float* src = m < MR ? a.x + (size_t)m * D : a.meta + (size_t)((m - MR) & 15) * D;
#pragma unroll
            for (int j = 0; j < 4; ++j) v[r][j] = ((const f32x4*)src)[lane + 64 * j]; }
#pragma unroll
        for (int r = 0; r < 4; ++r) { const int m = 4 * m4 + r; v2u* br = (v2u*)(hb + (size_t)m * D) + lane; float s = 0.f;
#pragma unroll
            for (int j = 0; j < 4; ++j) { const f32x4 x = v[r][j]; v2u w; w.x = pk2(x.x, x.y); w.y = pk2(x.z, x.w); br[64 * j] = w; s += (x.x * x.x + x.y * x.y) + (x.z * x.z + x.w * x.w); }
            s = wave_sum(s);
            if (lane == 0) ssq[m] = pg8::ssq_fix(s); }
    }
    for (int i = c * 512 + tid; i < 5 * M; i += G * 512) ssq[M + i] = 0ull;
}

struct MetaEpi { const pg8::ssq_t* ssq_in; bf16* obf; int ldc; const float* hin_meta; bf16* hb; pg8::ssq_t* ssq_out; float alpha; int dup; };
template <int MODE>
__device__ __forceinline__ void meta_gemm(LAS unsigned char* lds, const bf16* A  , int lda, int kst  , const bf16* Bt, int K, int ncc, const MetaEpi& e, int G, int c) {
    constexpr int NB = MODE == 0 ? 2 : 1, NP = 1 + NB, PSTR = 144, PANEL = 32 * PSTR, WREG = 14336;
    static_assert(NP * PANEL <= WREG && NB * 4096 <= WREG && 8 * WREG <= 131072, "meta LDS");
    int tid_ = threadIdx.x; asm volatile("" : "+v"(tid_));
    const int tid = tid_, lane = tid & 63, wave = __builtin_amdgcn_readfirstlane(tid >> 6), l32 = lane & 31, hh = lane >> 5;
    const int nst = K / 64, s0 = (nst * wave) >> 3, s1 = (nst * (wave + 1)) >> 3;
    LAS unsigned char* wl = lds + wave * WREG;
    const int lrow = lane >> 3, lch = lane & 7;
    const int dup = e.dup, nitems = dup ? ncc : 8 * ncc;
#pragma unroll 1
    for (int item = c; item < nitems; item += G) {
        const int rb = dup ? 0 : (item & 7), cc = dup ? item : (item >> 3);
        const bf16* ag = A + (size_t)(32 * rb + lrow) * lda + lch * 8;
        const bf16* bg[NB];
        if (MODE == 0) { const int ff0 = cc * 32; bg[0] = Bt + (size_t)((ff0 >> 7) * 256 + (ff0 & 127) + lrow) * K + lch * 8; bg[NB - 1] = bg[0] + (size_t)128 * K; }
        else bg[0] = Bt + (size_t)(cc * 32 + lrow) * K + lch * 8;
        f32x16 acc[NB];
#pragma unroll
        for (int p = 0; p < NB; ++p)
#pragma unroll
            for (int i = 0; i < 16; ++i) acc[p][i] = 0.f;
#pragma unroll 1
        for (int s = s0; s < s1; s += 2) {
            const bool two = (s + 1 < s1);
            v4u r[2][NP][4];
#pragma unroll
            for (int t = 0; t < 2; ++t) { const int st = (t == 1 && !two) ? s : s + t;
#pragma unroll
                for (int j = 0; j < 4; ++j) { r[t][0][j] = *(const v4u*)(ag + (size_t)st * kst + (size_t)(8 * j) * lda);
#pragma unroll
                    for (int p = 0; p < NB; ++p) r[t][1 + p][j] = *(const v4u*)(bg[p] + st * 64 + (size_t)(8 * j) * K); } }
#pragma unroll
            for (int t = 0; t < 2; ++t) {
                if (t == 1 && !two) break;
#pragma unroll
                for (int pn = 0; pn < NP; ++pn)
#pragma unroll
                    for (int j = 0; j < 4; ++j) *(LAS v4u*)(wl + pn * PANEL + (8 * j + lrow) * PSTR + lch * 16) = r[t][pn][j];
#pragma unroll
                for (int kk = 0; kk < 4; ++kk) { const bf16x8 af = *(const LAS bf16x8*)(wl + l32 * PSTR + (kk * 16 + hh * 8) * 2);
#pragma unroll
                    for (int p = 0; p < NB; ++p) { const bf16x8 bfr = *(const LAS bf16x8*)(wl + (1 + p) * PANEL + l32 * PSTR + (kk * 16 + hh * 8) * 2);
                        acc[p] = __builtin_amdgcn_mfma_f32_32x32x16_bf16(bfr, af, acc[p], 0, 0, 0); } }
            }
        }
#pragma unroll
        for (int p = 0; p < NB; ++p)
#pragma unroll
            for (int i = 0; i < 16; ++i) *(LAS float*)(wl + ((p * 16 + i) * 64 + lane) * 4) = acc[p][i];
        __syncthreads();
        float v[NB][2];
#pragma unroll
        for (int p = 0; p < NB; ++p) { v[p][0] = 0.f; v[p][1] = 0.f; }
#pragma unroll
        for (int w = 0; w < 8; ++w)
#pragma unroll
            for (int p = 0; p < NB; ++p)
#pragma unroll
                for (int q = 0; q < 2; ++q) v[p][q] += *(const LAS float*)(lds + w * WREG + ((p * 16 + 2 * wave + q) * 64 + lane) * 4);
        const int i0 = 2 * wave, col = cc * 32 + (i0 & 3) + 8 * (i0 >> 2) + 4 * hh, nrep = dup ? 8 : 1;
#pragma unroll 1
        for (int r8 = 0; r8 < nrep; ++r8) {
        const int row = MR + 32 * (rb + r8) + l32;
        if (MODE == 0) {
            const float rs = pg8::ssq_rs(e.ssq_in[row]); float av[2];
#pragma unroll
            for (int q = 0; q < 2; ++q) { const float gv = v[0][q] * rs, uv = v[NB - 1][q] * rs; av[q] = gv * __builtin_amdgcn_rcpf(1.0f + __builtin_amdgcn_exp2f(gv * -1.44269504089f)) * uv; }
            *(unsigned*)(e.obf + ((size_t)(128 * (e.ldc >> 6) + (col >> 6)) * 256 + (row - MR)) * 64 + (col & 63)) = pk2(av[0], av[1]);
        } else if (MODE == 1) {
            const float rs = pg8::ssq_rs(e.ssq_in[row]);
            *(unsigned*)(e.obf + (size_t)row * e.ldc + col) = pk2(v[0][0] * rs, v[0][1] * rs);
        } else {
            typedef float f32x2 __attribute__((ext_vector_type(2)));
            const size_t off = (size_t)row * D + col;
            f32x2 x;
            if (e.hin_meta) x = *(const f32x2*)(e.hin_meta + (size_t)((row - MR) & 15) * D + col);
            else { const unsigned r = *(const unsigned*)(e.hb + off); x.x = bflo(r); x.y = bfhi(r); }
            x.x += e.alpha * v[0][0]; x.y += e.alpha * v[0][1];
            *(unsigned*)(e.hb + off) = pk2(x.x, x.y);
            float part = x.x * x.x + x.y * x.y; part += __shfl_xor(part, 32);
            if (hh == 0) pg8::ssq_add(e.ssq_out + row, part);
        }
        }
        __syncthreads();
    }
}

constexpr int KSTR = 144, NSLOTP = 416, VSTR = 840, K_OFF = 0, V_OFF = NSLOTP * KSTR;
static_assert(V_OFF + 64 * VSTR <= 131072, "attention LDS");
constexpr int ATT_UNITS = BATCH * 4 * 16 + BATCH * 4;

__device__ __forceinline__ void attn_phase(LAS unsigned char* lds, const bf16* qkv, bf16* o, const float* qg, const float* kg, const float* sink, int G, int c) {
    int tid_ = threadIdx.x; asm volatile("" : "+v"(tid_));
    const int tid = tid_, lane = tid & 63, wave = __builtin_amdgcn_readfirstlane(tid >> 6), l32 = lane & 31, hh = lane >> 5;
    float kgmax = __builtin_fabsf(kg[lane]);
#pragma unroll
    for (int o = 1; o < 64; o <<= 1) kgmax = fmaxf(kgmax, __shfl_xor(kgmax, o));
    kgmax = __builtin_bit_cast(float, __builtin_amdgcn_readfirstlane(__builtin_bit_cast(int, kgmax)));
#pragma unroll 1
    for (int it = 0;; ++it) {
        int b, kh, j; bool meta, first;
        if (G == 256) {
            const int y = c >> 3;
            if (it < 4) { const int P = (c & 7) * 8 + (y >> 2); b = P >> 2; kh = P & 3; j = (y & 3) * 4 + it; meta = false; first = (it == 0); }
            else if (it == 4 && y < 8) { const int P = (c & 7) * 8 + y; b = P >> 2; kh = P & 3; j = 0; meta = true; first = true; }
            else break;
        } else {
            const int uidx = c + it * G; if (uidx >= ATT_UNITS) break;
            if (uidx < 1024) { b = uidx >> 6; kh = (uidx >> 4) & 3; j = uidx & 15; meta = false; } else { const int r = uidx - 1024; b = r >> 2; kh = r & 3; j = 0; meta = true; }
            first = true;
        }
        const int Blo = meta ? 0 : (j > 0 ? j - 1 : 0), Bhi = meta ? 0 : (j < 15 ? j + 1 : 15);
        const int qb = meta ? 0 : (wave & 3), hp = meta ? (wave & 1) : (wave >> 2);
        const int qlo = meta ? 0 : NMETA + 128 * j + 32 * qb, qhi = meta ? 15 : qlo + 31;
        const int qpos = meta ? (l32 & 15) : qlo + l32;
        const int head0 = kh * 4 + 2 * hp;
        v4u kr[7], vr[7];
#pragma unroll
        for (int i = 0; i < 7; ++i) {
            const int part = tid & 7, o = tid >> 3;
            kr[i] = (v4u){0u, 0u, 0u, 0u}; vr[i] = (v4u){0u, 0u, 0u, 0u};
            int pos = -1;
            if (i < 6) { const int Bc = (meta ? 0 : j - 1) + (i >> 1); if (Bc >= Blo && Bc <= Bhi && (first || Bc == j + 1) && !(meta && i >= 2)) pos = NMETA + 128 * Bc + 64 * (i & 1) + o; }
            else if (first && o < NMETA) pos = o;
            if (pos >= 0) { const bf16* rp = qkv + (size_t)rowof(b, pos) * QKVN + kh * 64 + part * 8; kr[i] = *(const v4u*)(rp + 1024); vr[i] = *(const v4u*)(rp + 1280); }
        }
        v4u qraw[2][4];
#pragma unroll
        for (int h = 0; h < 2; ++h) { const bf16* qp = qkv + (size_t)rowof(b, qpos) * QKVN + (head0 + h) * 64 + hh * 8;
#pragma unroll
            for (int kk = 0; kk < 4; ++kk) qraw[h][kk] = *(const v4u*)(qp + kk * 16); }
        __syncthreads();
#pragma unroll
        for (int i = 0; i < 7; ++i) {
            const int part = tid & 7, o = tid >> 3;
            int slot = -1;
            if (i < 6) { const int Bc = (meta ? 0 : j - 1) + (i >> 1); if (Bc >= Blo && Bc <= Bhi && (first || Bc == j + 1) && !(meta && i >= 2)) slot = (Bc % 3) * 128 + 64 * (i & 1) + o; }
            else if (first && o < 32) slot = 384 + o;
            const v4u kw = kr[i], vw = vr[i];
            float kf[8] = {bflo(kw.x), bfhi(kw.x), bflo(kw.y), bfhi(kw.y), bflo(kw.z), bfhi(kw.z), bflo(kw.w), bfhi(kw.w)};
            float ss = 0.f;
#pragma unroll
            for (int e = 0; e < 8; ++e) ss += kf[e] * kf[e];
            ss += __shfl_xor(ss, 1); ss += __shfl_xor(ss, 2); ss += __shfl_xor(ss, 4);
            const float rs = __builtin_amdgcn_rsqf(ss * (1.0f / 64.0f) + pg8::RMS_EPS);
            const f32x4 g0 = *(const f32x4*)(kg + part * 8), g1 = *(const f32x4*)(kg + part * 8 + 4);
            v4u kp; kp.x = pk2(kf[0] * rs * g0.x, kf[1] * rs * g0.y); kp.y = pk2(kf[2] * rs * g0.z, kf[3] * rs * g0.w);
            kp.z = pk2(kf[4] * rs * g1.x, kf[5] * rs * g1.y); kp.w = pk2(kf[6] * rs * g1.z, kf[7] * rs * g1.w);
            if (slot >= 0) {
                *(LAS v4u*)(lds + K_OFF + slot * KSTR + part * 16) = kp;
                LAS unsigned char* vb = lds + V_OFF + (part * 8) * VSTR + slot * 2;
                *(LAS unsigned short*)(vb + 0 * VSTR) = (unsigned short)(vw.x & 0xffffu); *(LAS unsigned short*)(vb + 1 * VSTR) = (unsigned short)(vw.x >> 16);
                *(LAS unsigned short*)(vb + 2 * VSTR) = (unsigned short)(vw.y & 0xffffu); *(LAS unsigned short*)(vb + 3 * VSTR) = (unsigned short)(vw.y >> 16);
                *(LAS unsigned short*)(vb + 4 * VSTR) = (unsigned short)(vw.z & 0xffffu); *(LAS unsigned short*)(vb + 5 * VSTR) = (unsigned short)(vw.z >> 16);
                *(LAS unsigned short*)(vb + 6 * VSTR) = (unsigned short)(vw.w & 0xffffu); *(LAS unsigned short*)(vb + 7 * VSTR) = (unsigned short)(vw.w >> 16);
            }
        }
        bf16x8 qf[2][4]; float slope2[2], sink2[2], mfix[2];
#pragma unroll
        for (int h = 0; h < 2; ++h) {
            float ss = 0.f;
#pragma unroll
            for (int kk = 0; kk < 4; ++kk) { const v4u w = qraw[h][kk];
                const float f0 = bflo(w.x), f1 = bfhi(w.x), f2 = bflo(w.y), f3 = bfhi(w.y), f4 = bflo(w.z), f5 = bfhi(w.z), f6 = bflo(w.w), f7 = bfhi(w.w);
                ss += (f0 * f0 + f1 * f1) + (f2 * f2 + f3 * f3) + (f4 * f4 + f5 * f5) + (f6 * f6 + f7 * f7); }
            ss += __shfl_xor(ss, 32);
            const float rs = __builtin_amdgcn_rsqf(ss * (1.0f / 64.0f) + pg8::RMS_EPS) * (0.125f * LOG2E);
            float qn2 = 0.f;
#pragma unroll
            for (int kk = 0; kk < 4; ++kk) { const f32x4 g0 = *(const f32x4*)(qg + kk * 16 + hh * 8), g1 = *(const f32x4*)(qg + kk * 16 + hh * 8 + 4); const v4u r = qraw[h][kk];
                const float q0 = bflo(r.x) * rs * g0.x, q1 = bfhi(r.x) * rs * g0.y, q2 = bflo(r.y) * rs * g0.z, q3 = bfhi(r.y) * rs * g0.w;
                const float q4 = bflo(r.z) * rs * g1.x, q5 = bfhi(r.z) * rs * g1.y, q6 = bflo(r.w) * rs * g1.z, q7 = bfhi(r.w) * rs * g1.w;
                qn2 += (q0 * q0 + q1 * q1) + (q2 * q2 + q3 * q3) + (q4 * q4 + q5 * q5) + (q6 * q6 + q7 * q7);
                v4u w; w.x = pk2(q0, q1); w.y = pk2(q2, q3); w.z = pk2(q4, q5); w.w = pk2(q6, q7);
                qf[h][kk] = __builtin_bit_cast(bf16x8, w); }
            qn2 += __shfl_xor(qn2, 32);
            mfix[h] = __builtin_sqrtf(qn2) * (8.0f * kgmax);
            slope2[h] = __builtin_bit_cast(float, __builtin_amdgcn_readfirstlane(__builtin_bit_cast(int, __builtin_amdgcn_exp2f(-0.5f * (float)(head0 + h + 1)) * LOG2E)));
            sink2[h] = __builtin_bit_cast(float, __builtin_amdgcn_readfirstlane(__builtin_bit_cast(int, sink[head0 + h] * LOG2E)));
        }
        __syncthreads();
        if (meta && wave >= 2) continue;
        f32x16 oacc[2][2];
#pragma unroll
        for (int h = 0; h < 2; ++h)
#pragma unroll
            for (int d = 0; d < 2; ++d)
#pragma unroll
                for (int i = 0; i < 16; ++i) oacc[h][d][i] = 0.f;
        float lrun[2] = {0.f, 0.f};
#pragma unroll 1
        for (int kb = 0; kb < 13; ++kb) {
            int plo = 0;
            if (kb < 12) {
                const int rp = kb >> 2;
                const int Bq = meta ? (rp == 0 ? 0 : -1) : (j - 1) + ((rp + 3 - (j + 2) % 3) % 3);
                if (Bq < Blo || Bq > Bhi) continue;
                plo = NMETA + 128 * Bq + 32 * (kb & 3);
                if (plo + 31 < qlo - 128 || plo > qhi + 128) continue;
            }
            const int phi = plo + 31;
            const bool full = kb < 12, inwin = plo >= qhi - 128 && phi <= qlo + 128;
            const float dqf = (float)(qpos - (plo + 4 * hh));
            bf16x8 pf[2][2];
#pragma unroll
            for (int h = 0; h < 2; ++h) {
                const float nsl = -slope2[h], m0 = -mfix[h];
                f32x16 s;
#pragma unroll
                for (int i = 0; i < 16; ++i) s[i] = m0;
#pragma unroll
                for (int kk = 0; kk < 4; ++kk) { const bf16x8 kfr = *(const LAS bf16x8*)(lds + K_OFF + (32 * kb + l32) * KSTR + (kk * 16 + hh * 8) * 2);
                    s = __builtin_amdgcn_mfma_f32_32x32x16_bf16(kfr, qf[h][kk], s, 0, 0, 0); }
                asm volatile("" ::: "memory");
                if (full) {
                    if (inwin) {
#pragma unroll
                        for (int i = 0; i < 16; ++i) s[i] = __builtin_fmaf(nsl, __builtin_fabsf(dqf - (float)(8 * (i >> 2) + (i & 3))), s[i]);
                    } else {
#pragma unroll
                        for (int i = 0; i < 16; ++i) { const float df = __builtin_fabsf(dqf - (float)(8 * (i >> 2) + (i & 3)));
                            const float v = __builtin_fmaf(nsl, df, s[i]); s[i] = df <= 128.0f ? v : -1e30f; }
                    }
                } else {
#pragma unroll
                    for (int i = 0; i < 16; ++i) {
                        const int mk = 8 * (i >> 2) + 4 * hh + (i & 3);
                        int dist = qpos - mk; dist = dist < 0 ? -dist : dist;
                        const bool ok = mk < NMETA;
                        s[i] = ok ? __builtin_fmaf(nsl, (float)dist, s[i]) : -1e30f;
                    }
                }
                float ps = 0.f;
#pragma unroll
                for (int i = 0; i < 16; ++i) { const float p = __builtin_amdgcn_exp2f(s[i]); s[i] = p; ps += p; }
                lrun[h] += ps;
#pragma unroll
                for (int jj = 0; jj < 2; ++jj) { v4u w; w.x = pk2(s[8 * jj + 0], s[8 * jj + 1]); w.y = pk2(s[8 * jj + 2], s[8 * jj + 3]);
                    w.z = pk2(s[8 * jj + 4], s[8 * jj + 5]); w.w = pk2(s[8 * jj + 6], s[8 * jj + 7]); pf[h][jj] = __builtin_bit_cast(bf16x8, w); }
            }
#pragma unroll
            for (int d = 0; d < 2; ++d)
#pragma unroll
                for (int jj = 0; jj < 2; ++jj) {
                    const LAS unsigned char* vb = lds + V_OFF + (32 * d + l32) * VSTR + (32 * kb + 16 * jj + 4 * hh) * 2;
                    const v2u lo = *(const LAS v2u*)vb, hi = *(const LAS v2u*)(vb + 16);
                    const bf16x8 vf = __builtin_bit_cast(bf16x8, (v4u){lo.x, lo.y, hi.x, hi.y});
#pragma unroll
                    for (int h = 0; h < 2; ++h) oacc[h][d] = __builtin_amdgcn_mfma_f32_32x32x16_bf16(vf, pf[h][jj], oacc[h][d], 0, 0, 0);
                }
        }
        const bool st = !meta || l32 < 16;
#pragma unroll
        for (int h = 0; h < 2; ++h) {
            const float lt = lrun[h] + __shfl_xor(lrun[h], 32) + __builtin_amdgcn_exp2f(sink2[h] - mfix[h]);
            const float inv = 1.0f / lt;
            bf16* op = o + (size_t)rowof(b, qpos) * D + (head0 + h) * 64 + 8 * hh;
#pragma unroll
            for (int d = 0; d < 2; ++d)
#pragma unroll
                for (int kp = 0; kp < 2; ++kp) {
                    const int i0 = 8 * kp, i1 = 8 * kp + 4;
                    unsigned ax = pk2(oacc[h][d][i0 + 0] * inv, oacc[h][d][i0 + 1] * inv), ay = pk2(oacc[h][d][i0 + 2] * inv, oacc[h][d][i0 + 3] * inv);
                    unsigned bx = pk2(oacc[h][d][i1 + 0] * inv, oacc[h][d][i1 + 1] * inv), by = pk2(oacc[h][d][i1 + 2] * inv, oacc[h][d][i1 + 3] * inv);
                    const auto rx = __builtin_amdgcn_permlane32_swap(ax, bx, false, false); ax = rx[0]; bx = rx[1];
                    const auto ry = __builtin_amdgcn_permlane32_swap(ay, by, false, false); ay = ry[0]; by = ry[1];
                    if (st) *(v4u*)(op + 32 * d + 16 * kp) = (v4u){ax, ay, bx, by};
                }
        }
    }
}

template <int H>
__device__ __forceinline__ void pool_run(const bf16* u, bf16* pl, int b, int l0, int cc) {
    v4u rw[2 * H + 3];
#pragma unroll
    for (int k = 0; k < 2 * H + 3; ++k) { const int s = l0 - H + k; rw[k] = (v4u){0u, 0u, 0u, 0u};
        if (s >= 0 && s < LTOK) rw[k] = *(const v4u*)(u + (size_t)rowof(b, s) * D + cc * 8); }
    float acc[8] = {0.f, 0.f, 0.f, 0.f, 0.f, 0.f, 0.f, 0.f};
#define POOL_ADD(k, sg) do { const v4u w_ = rw[k]; acc[0] += sg bflo(w_.x); acc[1] += sg bfhi(w_.x); acc[2] += sg bflo(w_.y); acc[3] += sg bfhi(w_.y); \
        acc[4] += sg bflo(w_.z); acc[5] += sg bfhi(w_.z); acc[6] += sg bflo(w_.w); acc[7] += sg bfhi(w_.w); } while (0)
#pragma unroll
    for (int k = 0; k < 2 * H; ++k) POOL_ADD(k, +);
#pragma unroll
    for (int j = 0; j < 4; ++j) {
        const int l = l0 + j;
        if (j > 0) { POOL_ADD(j - 1, -); POOL_ADD(j + 2 * H - 1, +); }
        const int lo = l - H > 0 ? l - H : 0, hi = l + H < LTOK ? l + H : LTOK;
        const float inv = 1.0f / (float)(hi - lo);
        const v4u w = rw[j + H];
        v4u ov; ov.x = pk2(acc[0] * inv - bflo(w.x), acc[1] * inv - bfhi(w.x)); ov.y = pk2(acc[2] * inv - bflo(w.y), acc[3] * inv - bfhi(w.y));
        ov.z = pk2(acc[4] * inv - bflo(w.z), acc[5] * inv - bfhi(w.z)); ov.w = pk2(acc[6] * inv - bflo(w.w), acc[7] * inv - bfhi(w.w));
        *(v4u*)(pl + (size_t)rowof(b, l) * D + cc * 8) = ov;
    }
#undef POOL_ADD
}
__device__ __forceinline__ void pool_phase(const bf16* u, bf16* pl, int G, int c) {
    int tid_ = threadIdx.x; asm volatile("" : "+v"(tid_));
    const int tid = tid_;
    for (int it = c * 512 + tid; it < BATCH * 4 * 512 * 32; it += G * 512) {
        const int cl = it & 31, r = (it >> 5) & 511, grp = (it >> 14) & 3, b = it >> 16;
        const int cc = grp * 32 + cl, l0 = NMETA + 4 * r;
        if (grp == 0) pool_run<1>(u, pl, b, l0, cc); else if (grp == 1) pool_run<2>(u, pl, b, l0, cc); else if (grp == 2) pool_run<4>(u, pl, b, l0, cc); else pool_run<8>(u, pl, b, l0, cc);
    }
}

#define XB_TMO      128
#define XB_XCNT(j)  (256  + 64 * (j))
#define XB_XSUB(j)  (1280 + 64 * (j))
#define XB_XGEN(j)  (2304 + 64 * (j))
#define XB_TOP      3328
#define XB_TOPGEN   3392
#define XCD_BAR_WORDS 3456
#define XB_SPIN_CAP (1u << 18)

__device__ __forceinline__ unsigned xb_ld(unsigned* p)              { return __hip_atomic_load(p, __ATOMIC_RELAXED, __HIP_MEMORY_SCOPE_AGENT); }
__device__ __forceinline__ unsigned xb_add(unsigned* p, unsigned v) { return __hip_atomic_fetch_add(p, v, __ATOMIC_RELAXED, __HIP_MEMORY_SCOPE_AGENT); }
__device__ __forceinline__ unsigned xb_xcc_id() { return (unsigned)__builtin_amdgcn_s_getreg((3 << 11) | 20) & 0xFu; }
#define XB_SPIN(cond, bar) do { unsigned _sp = 0; while (cond) { __builtin_amdgcn_s_sleep(1); \
    if ((++_sp & 255u) == 0u) { if (xb_ld(&(bar)[XB_TMO])) break; if (_sp > XB_SPIN_CAP) { atomicAdd(&(bar)[XB_TMO], 1u); break; } } } } while (0)

struct XcdBarrier {
    unsigned* bar; unsigned x;
    volatile LAS unsigned* st;
};

__device__ __forceinline__ XcdBarrier xcd_barrier_post(unsigned* bar, volatile LAS unsigned* st) {
    XcdBarrier b; b.bar = bar; b.x = xb_xcc_id(); b.st = st;
    if (threadIdx.x == 0) (void)xb_add(&bar[XB_XCNT(b.x)], 1u);
    return b;
}
__device__ __forceinline__ void xcd_barrier_complete(unsigned* bar, unsigned x, unsigned& nloc, unsigned& nx) {
    const unsigned G = gridDim.x * gridDim.y * gridDim.z;
    unsigned sum, cnt, mine, sp = 0u;
    for (;;) {
        sum = 0u; cnt = 0u; mine = 0u;
#pragma unroll
        for (unsigned j = 0; j < 16; ++j) { const unsigned c = xb_ld(&bar[XB_XCNT(j)]); sum += c; cnt += (c > 0u) ? 1u : 0u; mine = (j == x) ? c : mine; }
        if (sum == G) break;
        __builtin_amdgcn_s_sleep(1);
        if ((++sp & 255u) == 0u) { if (xb_ld(&bar[XB_TMO])) break; if (sp > XB_SPIN_CAP) { atomicAdd(&bar[XB_TMO], 1u); break; } }
    }
    nloc = mine > 0u ? mine : 1u; nx = cnt > 0u ? cnt : 1u;
}

__device__ __forceinline__ void xcd_barrier(const XcdBarrier& b) {
    asm volatile("s_waitcnt vmcnt(0)" ::: "memory");
    __syncthreads();
    if (threadIdx.x == 0) {
        unsigned* bar = b.bar;
        __builtin_amdgcn_s_waitcnt(0);
        unsigned nloc = b.st[0], nx = b.st[1];
        if (nloc == 0u) { xcd_barrier_complete(bar, b.x, nloc, nx); b.st[0] = nloc; b.st[1] = nx; }
        const unsigned old = xb_add(&bar[XB_XSUB(b.x)], 1u);
        const unsigned gen = old / nloc;
        if (old + 1u == (gen + 1u) * nloc) {
            __builtin_amdgcn_fence(__ATOMIC_RELEASE, "agent");
            asm volatile("s_waitcnt vmcnt(0)" ::: "memory");
            const unsigned og = xb_add(&bar[XB_TOP], 1u);
            const unsigned tg = og / nx;
            if (og + 1u == (tg + 1u) * nx) xb_add(&bar[XB_TOPGEN], 1u);
            else XB_SPIN(xb_ld(&bar[XB_TOPGEN]) == tg, bar);
            __builtin_amdgcn_fence(__ATOMIC_ACQUIRE, "agent");
            xb_add(&bar[XB_XGEN(b.x)], 1u);
            asm volatile("s_waitcnt vmcnt(0)" ::: "memory");
        } else {
            XB_SPIN(xb_ld(&bar[XB_XGEN(b.x)]) == gen, bar);
            __builtin_amdgcn_fence(__ATOMIC_ACQUIRE, "agent");
            asm volatile("s_waitcnt vmcnt(0)" ::: "memory");
        }
    }
    __syncthreads();
}

__global__ void __launch_bounds__(512, 2) fwd_megakernel(Args a) {
    extern __shared__ __attribute__((aligned(16))) unsigned char lds_raw[];
    LAS unsigned char* lds = (LAS unsigned char*)lds_raw;
    cg::grid_group grid = cg::this_grid();
    const int G = gridDim.x, c = blockIdx.x;
    unsigned char* ws = a.ws;
    bf16* hb = (bf16*)(ws + WS_HB); pg8::ssq_t* ssq = (pg8::ssq_t*)(ws + WS_SSQ); bf16* act = (bf16*)(ws + WS_ACT);

    if (c == 0) { unsigned* bw = (unsigned*)(ws + WS_BAR); for (int i = threadIdx.x; i < XCD_BAR_WORDS; i += 512) bw[i] = 0u; }
    if (threadIdx.x < 2) ((volatile LAS unsigned*)(lds + XB_LDS_OFF))[threadIdx.x] = 0u;
    prologue(a, lds, G, c);
    grid.sync();
    const XcdBarrier xbar = xcd_barrier_post((unsigned*)(ws + WS_BAR), (volatile LAS unsigned*)(lds + XB_LDS_OFF));

    int np = 0;
#pragma unroll 1
    for (int f = 0; f < 4; ++f) {
        {
            if (f < 3) { const MetaEpi me{ssq + (size_t)np * M, act, FF, nullptr, nullptr, nullptr, 0.f, f == 0 ? 1 : 0};
                meta_gemm<0>(lds, hb + (size_t)MR * D, D, 64, (const bf16*)(ws + WS_WGU) + (size_t)f * NGU * D, D, FF / 32, me, G, c); }
            pg8::Gemm g{hb, (const bf16*)(ws + WS_WGU) + (size_t)f * NGU * D, MR, NGU, D, D, 0, 128u, (size_t)256 * D * 2}; pg8::StaticOrder S; S.init(MR, NGU, G, c, REV_GU);
            pg8::EpiGU E{act, FF, ssq + (size_t)np * M};
            pg8::gemm_phase<pg8::EpiGU, pg8::StaticOrder, true, true>(lds, g, S, E);
        }
        GSYNC();
        {
            if (f < 3) { const MetaEpi me{nullptr, nullptr, 0, f == 0 ? a.meta : nullptr, hb, ssq + (size_t)(np + 1) * M, 0.5f, f == 0 ? 1 : 0};
                meta_gemm<2>(lds, act + (size_t)128 * (FF / 64) * 16384, 64, 16384, (const bf16*)(ws + WS_WDN) + (size_t)f * D * FF, FF, D / 32, me, G, c); }
            pg8::Gemm g{act, (const bf16*)(ws + WS_WDN) + (size_t)f * D * FF, MR, D, FF, 64, 0, 32768u, (size_t)(FF / 64) * 32768}; pg8::StaticOrder S; S.init(MR, D, G, c, REV_DOWN);
            pg8::EpiResid E{f == 0 ? a.x : nullptr, f == 0 ? a.meta : nullptr, hb, ssq + (size_t)(np + 1) * M, a.out, 0.5f, f == 3 ? 1 : 0};
            pg8::gemm_phase<pg8::EpiResid, pg8::StaticOrder, true, true>(lds, g, S, E);
        }
        ++np;
        if (f == 3) break;
        GSYNC();
        if (f == 0 || f == 2) {
            const bool is_attn = (f == 0);
            {
                const int N = is_attn ? QKVN : D;
                { const MetaEpi me{ssq + (size_t)np * M, (bf16*)(ws + WS_ACT), N, nullptr, nullptr, nullptr, 0.f, is_attn ? 1 : 0};
                  meta_gemm<1>(lds, hb + (size_t)MR * D, D, 64, (const bf16*)(ws + (is_attn ? WS_WQKV : WS_WPIN)), D, N / 32, me, G, c); }
                pg8::Gemm g{hb, (const bf16*)(ws + (is_attn ? WS_WQKV : WS_WPIN)), MR, N, D, D, 0, 128u, (size_t)256 * D * 2}; pg8::StaticOrder S; S.init(MR, N, G, c);
                pg8::EpiBf16S E{(bf16*)(ws + WS_ACT), N, ssq + (size_t)np * M};
                pg8::gemm_phase<pg8::EpiBf16S, pg8::StaticOrder, true, true>(lds, g, S, E);
            }
            GSYNC();
            if (is_attn) {
                attn_phase(lds, (const bf16*)(ws + WS_QKV), (bf16*)(ws + WS_O), a.q_norm, a.k_norm, a.sink, G, c);
                __syncthreads();
            } else {
                pool_phase((const bf16*)(ws + WS_U), (bf16*)(ws + WS_PL), G, c);
                GSYNC();
                {
                    pg8::Gemm g{(const bf16*)(ws + WS_PL), (const bf16*)(ws + WS_WGRP), MR, D, 256, D, 256, 128u, (size_t)256 * D * 2}; pg8::StaticOrder S; S.init(MR, D, G, c);
                    pg8::EpiBf16S E{(bf16*)(ws + WS_MX), D, nullptr};
                    pg8::gemm_phase<pg8::EpiBf16S, pg8::StaticOrder, true, true>(lds, g, S, E);
                }
            }
            GSYNC();
            {
                if (is_attn) { const MetaEpi me{nullptr, nullptr, 0, nullptr, hb, ssq + (size_t)(np + 1) * M, 1.0f, 0};
                    meta_gemm<2>(lds, (const bf16*)(ws + WS_O) + (size_t)MR * D, D, 64, (const bf16*)(ws + WS_WO), D, D / 32, me, G, c); }
                pg8::Gemm g{(const bf16*)(ws + (is_attn ? WS_O : WS_MX)), (const bf16*)(ws + (is_attn ? WS_WO : WS_WPOUT)), MR, D, D, D, 0, 128u, (size_t)256 * D * 2}; pg8::StaticOrder S; S.init(MR, D, G, c);
                pg8::EpiResid E{nullptr, nullptr, hb, ssq + (size_t)(np + 1) * M, a.out, 1.0f, 0};
                pg8::gemm_phase<pg8::EpiResid, pg8::StaticOrder, true, true>(lds, g, S, E);
            }
            ++np;
            GSYNC();
        }
    }
}

extern "C" void kernel_launch(void* const* d_in, const int* in_sizes, int n_in, void* d_out, int out_size, void* d_ws, size_t ws_size, hipStream_t stream) {
    static int grid = 0;
    if (grid == 0) {
        if (n_in != 15 || ws_size < WS_END) { fprintf(stderr, "kernel_launch: expected 15 inputs and >= %zu bytes of workspace (got %d, %zu)\n", (size_t)WS_END, n_in, ws_size); grid = -1; return; }
        int dev = 0, cus = 0, per_cu = 0;
        hipGetDevice(&dev); hipDeviceGetAttribute(&cus, hipDeviceAttributeMultiprocessorCount, dev);
        if (hipFuncSetAttribute((const void*)fwd_megakernel, hipFuncAttributeMaxDynamicSharedMemorySize, LDS_BYTES) != hipSuccess) { fprintf(stderr, "kernel_launch: hipFuncSetAttribute failed\n"); grid = -1; return; }
        if (hipOccupancyMaxActiveBlocksPerMultiprocessor(&per_cu, (const void*)fwd_megakernel, 512, LDS_BYTES) != hipSuccess || per_cu < 1) { fprintf(stderr, "kernel_launch: occupancy query says %d blocks per CU\n", per_cu); per_cu = 1; }
        (void)hipGetLastError();
        grid = cus * 1;
    }
    if (grid < 0) return;
    Args a{};
    a.x = (const float*)d_in[0]; a.meta = (const float*)d_in[1]; a.ffn_norm = (const float*)d_in[2]; a.w_gu = (const float*)d_in[3]; a.w_down = (const float*)d_in[4];
    a.mixer_norm = (const float*)d_in[5]; a.w_qkv = (const float*)d_in[6]; a.q_norm = (const float*)d_in[7]; a.k_norm = (const float*)d_in[8]; a.sink = (const float*)d_in[9];
    a.w_o = (const float*)d_in[10]; a.w_pin = (const float*)d_in[11]; a.w_grp = (const float*)d_in[12]; a.pool_scale = (const float*)d_in[13]; a.w_pout = (const float*)d_in[14];
    a.out = (float*)d_out; a.ws = (unsigned char*)d_ws;
    void* args[] = {&a};
    hipError_t e = hipLaunchCooperativeKernel((const void*)fwd_megakernel, dim3(grid), dim3(512), args, LDS_BYTES, stream);
    if (e != hipSuccess) fprintf(stderr, "kernel_launch: cooperative launch failed: %s (grid %d)\n", hipGetErrorString(e), grid);
}
```
